# Optimizing an MI355X kernel written in HIP

```python
import jax, jax.numpy as jnp
from jax import lax
import numpy as np

D_MODEL = 1024
BATCH = 16
SEQ = 2048
DEPTH = 2
DEC_BATCH = 32
DEC_SEQ = 32
PAST_LEN = 2048

CHUNK = 64
MIX_WIDTH = D_MODEL
POOL_WIDTH = MIX_WIDTH // 2
CONV_WIDTH = MIX_WIDTH - POOL_WIDTH
POOL_WINDOWS = (2, 4, 8, 16)
N_POOL_GROUPS = len(POOL_WINDOWS)
POOL_GROUP = POOL_WIDTH // N_POOL_GROUPS
POOL_HIST = max(POOL_WINDOWS) - 1
CONV_K = 3
IN_WIDTH = POOL_WIDTH + 3 * CONV_WIDTH
N_MEM = 256
N_MEM_HEADS = 4
MEM_HEAD_DIM = D_MODEL // N_MEM_HEADS
D_FF = 2816
FFN_CONV_K = 3
EPS = 1e-6

kernel_name = "hybrid_pool_shortconv_stream_step"


def rms_norm(x, g):
    x32 = x.astype(jnp.float32)
    y = x32 * lax.rsqrt(jnp.mean(x32 * x32, axis=-1, keepdims=True) + EPS)
    return (y * g.astype(jnp.float32)).astype(x.dtype)


def causal_dwconv3(z, hist, w, b):
    t = z.shape[1]
    ext = jnp.concatenate([hist.astype(z.dtype), z], axis=1)
    y = ext[:, 0:t] * w[0] + ext[:, 1:t + 1] * w[1] + ext[:, 2:t + 2] * w[2] + b
    return y, ext[:, -2:]


def multiscale_pool(u, hist, start_pos, w_pool, scale):
    b, t, c = u.shape
    ext = jnp.concatenate([hist.astype(u.dtype), u], axis=1)
    cs = jnp.cumsum(ext.astype(jnp.float32), axis=1)
    cs = jnp.pad(cs, ((0, 0), (1, 0), (0, 0)))
    pos = start_pos + jnp.arange(t)
    p1 = POOL_HIST + 1
    means = []
    for g, w in enumerate(POOL_WINDOWS):
        lo, hi = g * POOL_GROUP, (g + 1) * POOL_GROUP
        s = cs[:, p1:p1 + t, lo:hi] - cs[:, p1 - w:p1 - w + t, lo:hi]
        cnt = jnp.minimum(w, pos + 1).astype(jnp.float32)[None, :, None]
        means.append(s / cnt)
    mean = jnp.concatenate(means, axis=-1)
    d = (mean - u.astype(jnp.float32)).astype(u.dtype)
    d = d.reshape(b, t, N_POOL_GROUPS, POOL_GROUP)
    y = jnp.einsum('btgc,gcd->btgd', d, w_pool).reshape(b, t, c) * scale
    return y, ext[:, -POOL_HIST:]


def memory_kv(mem, g_mem, w_k, w_v):
    m = rms_norm(mem, g_mem)
    k = jnp.einsum('bmd,dhe->bmhe', m, w_k)
    v = jnp.einsum('bmd,dhe->bmhe', m, w_v)
    return k, v


def memory_attention(h, k, v, w_q, w_o):
    q = jnp.einsum('btd,dhe->bthe', h, w_q)
    s = jnp.einsum('bthe,bmhe->bhtm', q, k).astype(jnp.float32) * (MEM_HEAD_DIM ** -0.5)
    p = jax.nn.softmax(s, axis=-1).astype(v.dtype)
    o = jnp.einsum('bhtm,bmhe->bthe', p, v)
    return jnp.einsum('bthe,hed->btd', o, w_o)


def layer_step(x, mem_k, mem_v, pool_hist, conv_hist, ffn_hist, start_pos, lw):
    h = rms_norm(x, lw['g_mix_pre'])
    proj = h @ lw['w_in']
    u_a = proj[..., :POOL_WIDTH]
    b_gate, c_gate, val = jnp.split(proj[..., POOL_WIDTH:], 3, axis=-1)
    y_a, pool_new = multiscale_pool(u_a, pool_hist, start_pos, lw['w_pool'], lw['pool_scale'])
    zc, conv_new = causal_dwconv3(c_gate * val, conv_hist, lw['conv_w'], lw['conv_b'])
    y_b = b_gate * zc
    y = jnp.concatenate([y_a, y_b], axis=-1) @ lw['w_out']
    x = x + rms_norm(y, lw['g_mix_post'])
    h = rms_norm(x, lw['g_attn_pre'])
    y = memory_attention(h, mem_k, mem_v, lw['w_q'], lw['w_o'])
    x = x + rms_norm(y, lw['g_attn_post'])
    h = rms_norm(x, lw['g_ffn_pre'])
    up = h @ lw['w_up']
    upc, ffn_new = causal_dwconv3(up, ffn_hist, lw['ffn_conv_w'], lw['ffn_conv_b'])
    gate, value = jnp.split(upc, 2, axis=-1)
    y = (jax.nn.silu(gate) * value) @ lw['w_down']
    x = x + rms_norm(y, lw['g_ffn_post'])
    return x, pool_new, conv_new, ffn_new


def setup_inputs(seed: int = 0) -> dict:
    key = jax.random.key(seed)
    ks = jax.random.split(key, 32)
    f32 = jnp.float32
    L = DEPTH

    def nrm(k, shape, scale):
        return jax.random.normal(k, shape, f32) * scale

    def gain(k, shape):
        return 1.0 + 0.05 * jax.random.normal(k, shape, f32)

    return {
        'x_prompt': nrm(ks[0], (BATCH, SEQ, D_MODEL), 1.0),
        'x_sample': nrm(ks[1], (DEC_BATCH, DEC_SEQ, D_MODEL), 1.0),
        'mem_prompt': nrm(ks[2], (BATCH, N_MEM, D_MODEL), 1.0),
        'cache_mem_k': nrm(ks[3], (L, DEC_BATCH, N_MEM, N_MEM_HEADS, MEM_HEAD_DIM), 1.0),
        'cache_mem_v': nrm(ks[4], (L, DEC_BATCH, N_MEM, N_MEM_HEADS, MEM_HEAD_DIM), 1.0),
        'state_pool': nrm(ks[5], (L, DEC_BATCH, POOL_HIST, POOL_WIDTH), 1.0),
        'state_conv': nrm(ks[6], (L, DEC_BATCH, CONV_K - 1, CONV_WIDTH), 1.0),
        'state_ffn_conv': nrm(ks[7], (L, DEC_BATCH, FFN_CONV_K - 1, 2 * D_FF), 1.0),
        'g_mix_pre': gain(ks[8], (L, D_MODEL)),
        'g_mix_post': gain(ks[9], (L, D_MODEL)),
        'w_in': nrm(ks[10], (L, D_MODEL, IN_WIDTH), D_MODEL ** -0.5),
        'w_pool': nrm(ks[11], (L, N_POOL_GROUPS, POOL_GROUP, POOL_GROUP), POOL_GROUP ** -0.5),
        'pool_scale': gain(ks[12], (L, POOL_WIDTH)),
        'conv_w': nrm(ks[13], (L, CONV_K, CONV_WIDTH), CONV_K ** -0.5),
        'conv_b': nrm(ks[14], (L, CONV_WIDTH), 0.01),
        'w_out': nrm(ks[15], (L, MIX_WIDTH, D_MODEL), MIX_WIDTH ** -0.5),
        'g_attn_pre': gain(ks[16], (L, D_MODEL)),
        'g_attn_post': gain(ks[17], (L, D_MODEL)),
        'g_mem': gain(ks[18], (L, D_MODEL)),
        'w_q': nrm(ks[19], (L, D_MODEL, N_MEM_HEADS, MEM_HEAD_DIM), D_MODEL ** -0.5),
        'w_k': nrm(ks[20], (L, D_MODEL, N_MEM_HEADS, MEM_HEAD_DIM), D_MODEL ** -0.5),
        'w_v': nrm(ks[21], (L, D_MODEL, N_MEM_HEADS, MEM_HEAD_DIM), D_MODEL ** -0.5),
        'w_o': nrm(ks[22], (L, N_MEM_HEADS, MEM_HEAD_DIM, D_MODEL), D_MODEL ** -0.5),
        'g_ffn_pre': gain(ks[23], (L, D_MODEL)),
        'g_ffn_post': gain(ks[24], (L, D_MODEL)),
        'w_up': nrm(ks[25], (L, D_MODEL, 2 * D_FF), D_MODEL ** -0.5),
        'ffn_conv_w': nrm(ks[26], (L, FFN_CONV_K, 2 * D_FF), FFN_CONV_K ** -0.5),
        'ffn_conv_b': nrm(ks[27], (L, 2 * D_FF), 0.01),
        'w_down': nrm(ks[28], (L, D_FF, D_MODEL), D_FF ** -0.5),
    }


def reference(x_prompt, x_sample, mem_prompt, cache_mem_k, cache_mem_v, state_pool, state_conv,
              state_ffn_conv, g_mix_pre, g_mix_post, w_in, w_pool, pool_scale, conv_w, conv_b, w_out,
              g_attn_pre, g_attn_post, g_mem, w_q, w_k, w_v, w_o, g_ffn_pre, g_ffn_post, w_up,
              ffn_conv_w, ffn_conv_b, w_down):
    yp, ys = x_prompt, x_sample
    bp = x_prompt.shape[0]
    mk_p, mv_p, pool_p, conv_p, ffn_p = [], [], [], [], []
    pool_s, conv_s, ffn_s = [], [], []
    for l in range(DEPTH):
        lw = {
            'g_mix_pre': g_mix_pre[l], 'g_mix_post': g_mix_post[l], 'w_in': w_in[l],
            'w_pool': w_pool[l], 'pool_scale': pool_scale[l], 'conv_w': conv_w[l], 'conv_b': conv_b[l],
            'w_out': w_out[l], 'g_attn_pre': g_attn_pre[l], 'g_attn_post': g_attn_post[l],
            'w_q': w_q[l], 'w_o': w_o[l], 'g_ffn_pre': g_ffn_pre[l], 'g_ffn_post': g_ffn_post[l],
            'w_up': w_up[l], 'ffn_conv_w': ffn_conv_w[l], 'ffn_conv_b': ffn_conv_b[l], 'w_down': w_down[l],
        }
        kp, vp = memory_kv(mem_prompt, g_mem[l], w_k[l], w_v[l])
        yp, pn, cn, fn = layer_step(
            yp, kp, vp,
            jnp.zeros((bp, POOL_HIST, POOL_WIDTH), yp.dtype),
            jnp.zeros((bp, CONV_K - 1, CONV_WIDTH), yp.dtype),
            jnp.zeros((bp, FFN_CONV_K - 1, 2 * D_FF), yp.dtype),
            0, lw)
        mk_p.append(kp)
        mv_p.append(vp)
        pool_p.append(pn)
        conv_p.append(cn)
        ffn_p.append(fn)
        ys, pn, cn, fn = layer_step(ys, cache_mem_k[l], cache_mem_v[l], state_pool[l], state_conv[l],
                                    state_ffn_conv[l], PAST_LEN, lw)
        pool_s.append(pn)
        conv_s.append(cn)
        ffn_s.append(fn)
    return (yp, ys, jnp.stack(mk_p), jnp.stack(mv_p), jnp.stack(pool_p), jnp.stack(conv_p),
            jnp.stack(ffn_p), jnp.stack(pool_s), jnp.stack(conv_s), jnp.stack(ffn_s))
```

```cpp
#include <hip/hip_runtime.h>
#include <hip/hip_cooperative_groups.h>
#include <cstdio>
namespace cg = cooperative_groups;

#define LAS __attribute__((address_space(3)))
typedef unsigned short bf16_t;
typedef short bf16x8 __attribute__((ext_vector_type(8)));
typedef float f32x4 __attribute__((ext_vector_type(4)));
typedef unsigned u32x4 __attribute__((ext_vector_type(4)));
typedef unsigned u32x2 __attribute__((ext_vector_type(2)));

constexpr int DM = 1024;
constexpr int MP = 32768;
constexpr int MT = 33792;
constexpr int NUP = 5632, DFF = 2816;
constexpr int LDS_XTRA = 131072 + 256;
constexpr int LDS_ST = LDS_XTRA + 16 * 1536;
constexpr int LDS_BYTES = LDS_ST + 16;
constexpr int DT_PITCH = 1040;

enum { I_XP = 0, I_XS, I_MEM, I_CK, I_CV, I_SPOOL, I_SCONV, I_SFFN, I_GMIXPRE, I_GMIXPOST, I_WIN, I_WPOOL, I_PSCALE, I_CONVW, I_CONVB,
       I_WOUT, I_GATTPRE, I_GATTPOST, I_GMEM, I_WQ, I_WK, I_WV, I_WO, I_GFFNPRE, I_GFFNPOST, I_WUP, I_FCW, I_FCB, I_WDOWN };

constexpr size_t O_Y = 0, O_MK = 34603008, O_MV = 42991616, O_POOLP = 51380224, O_CONVP = 51625984, O_FFNP = 51658752,
                 O_POOLS = 52019200, O_CONVS = 52510720, O_FFNS = 52576256;

constexpr size_t MiB = 1048576;
constexpr size_t WL_WIN = 0, WL_WOUT = 2097152, WL_WQ = 3145728, WL_WO = 4194304, WL_WUP = 5242880, WL_WDOWN = 11010048, WL_POOL = 13893632,
                 WL_ELEMS = 14155776;
constexpr size_t WS_W = 0, WS_KP = 54 * MiB, WS_VPT = 70 * MiB, WS_KC = 86 * MiB, WS_VCT = 102 * MiB, WS_H = 118 * MiB, WS_Y = 184 * MiB,
                 WS_BIG = 250 * MiB;
constexpr size_t WS_RS = 481 * MiB + 16384;
constexpr size_t WS_VROW = 484 * MiB;
constexpr size_t WS_CTL = 481 * MiB;
constexpr size_t WS_MEMN = WS_Y, WS_WKV = WS_Y + 16 * MiB;
constexpr size_t BIG_PROJ = WS_BIG, BIG_DD = WS_BIG + 132 * MiB, BIG_YCAT = WS_BIG + 165 * MiB;
constexpr size_t BIG_Q = WS_BIG, BIG_O = WS_BIG + 66 * MiB;
constexpr size_t BIG_ACT = WS_BIG, BIG_RAW = WS_BIG + 182 * MiB;

struct Params { const float* in[29]; float* out; unsigned char* ws; };
typedef const __attribute__((address_space(4))) Params* PP;

typedef __bf16 bf16x2_t __attribute__((ext_vector_type(2)));
typedef float f32x2_t __attribute__((ext_vector_type(2)));
__device__ __forceinline__ unsigned cvt_pk_bf16(float lo, float hi) { const f32x2_t v = {lo, hi}; const bf16x2_t b = __builtin_convertvector(v, bf16x2_t); return __builtin_bit_cast(unsigned, b); }
__device__ __forceinline__ float bf_lo(unsigned w) { return __uint_as_float(w << 16); }
__device__ __forceinline__ float bf_hi(unsigned w) { return __uint_as_float(w & 0xffff0000u); }
__device__ __forceinline__ void unpack8(const u32x4 w, float* f) {
    f[0] = bf_lo(w.x); f[1] = bf_hi(w.x); f[2] = bf_lo(w.y); f[3] = bf_hi(w.y); f[4] = bf_lo(w.z); f[5] = bf_hi(w.z); f[6] = bf_lo(w.w); f[7] = bf_hi(w.w); }
__device__ __forceinline__ u32x4 pack8(const float* f) { u32x4 w; w.x = cvt_pk_bf16(f[0], f[1]); w.y = cvt_pk_bf16(f[2], f[3]); w.z = cvt_pk_bf16(f[4], f[5]); w.w = cvt_pk_bf16(f[6], f[7]); return w; }
__device__ __forceinline__ float shfl_xor_l(float v, int o, int lane) { return __int_as_float(__builtin_amdgcn_ds_bpermute((lane ^ o) << 2, __float_as_int(v))); }
__device__ __forceinline__ float wave_sum(float v, int lane) { for (int o = 32; o >= 1; o >>= 1) v += shfl_xor_l(v, o, lane); return v; }
template <int K> __device__ __forceinline__ float row_shift(float prev, float cur) {
    int t = __builtin_amdgcn_mov_dpp(__float_as_int(prev), 0x100 + (16 - K), 0xf, 0xf, false);
    int r = __builtin_amdgcn_update_dpp(t, __float_as_int(cur), 0x110 + K, 0xf, 0xf, false);
    return __int_as_float(r);
}
__device__ __forceinline__ float silu_f(float z) { return z * __builtin_amdgcn_rcpf(1.0f + __builtin_amdgcn_exp2f(-1.44269504f * z)); }


#define XB_TMO      128
#define XB_XCNT(j)  (256  + 64 * (j))
#define XB_XSUB(j)  (1280 + 64 * (j))
#define XB_XGEN(j)  (2304 + 64 * (j))
#define XB_TOP      3328
#define XB_TOPGEN   3392
#define XCD_BAR_WORDS 3456
#define XB_SPIN_CAP (1u << 18)
__device__ __forceinline__ unsigned xb_ld(unsigned* p)              { return __hip_atomic_load(p, __ATOMIC_RELAXED, __HIP_MEMORY_SCOPE_AGENT); }
__device__ __forceinline__ unsigned xb_add(unsigned* p, unsigned v) { return __hip_atomic_fetch_add(p, v, __ATOMIC_RELAXED, __HIP_MEMORY_SCOPE_AGENT); }
__device__ __forceinline__ unsigned xb_xcc_id() { return (unsigned)__builtin_amdgcn_s_getreg((3 << 11) | 20) & 0xFu; }
#define XB_SPIN(cond, bar) do { unsigned _sp = 0; while (cond) { __builtin_amdgcn_s_sleep(1); \
    if ((++_sp & 255u) == 0u) { if (xb_ld(&(bar)[XB_TMO])) break; if (_sp > XB_SPIN_CAP) { atomicAdd(&(bar)[XB_TMO], 1u); break; } } } } while (0)
struct XcdBarrier { unsigned* bar; unsigned x; volatile LAS unsigned* st; };
__device__ __forceinline__ XcdBarrier xcd_barrier_post(unsigned* bar, volatile LAS unsigned* st, int tid) {
    XcdBarrier b; b.bar = bar; b.x = xb_xcc_id(); b.st = st;
    if (tid == 0) (void)xb_add(&bar[XB_XCNT(b.x)], 1u);
    return b;
}
__device__ __forceinline__ void xcd_barrier_complete(unsigned* bar, unsigned x, unsigned G, unsigned& nloc, unsigned& nx) {
    unsigned sum, cnt, mine, sp = 0u;
    for (;;) {
        sum = 0u; cnt = 0u; mine = 0u;
#pragma unroll
        for (unsigned j = 0; j < 16; ++j) { const unsigned c = xb_ld(&bar[XB_XCNT(j)]); sum += c; cnt += (c > 0u) ? 1u : 0u; mine = (j == x) ? c : mine; }
        if (sum == G) break;
        __builtin_amdgcn_s_sleep(1);
        if ((++sp & 255u) == 0u) { if (xb_ld(&bar[XB_TMO])) break; if (sp > XB_SPIN_CAP) { atomicAdd(&bar[XB_TMO], 1u); break; } }
    }
    nloc = mine > 0u ? mine : 1u; nx = cnt > 0u ? cnt : 1u;
}
__device__ __forceinline__ void xcd_barrier(const XcdBarrier& b, int tid, unsigned G) {
    asm volatile("s_waitcnt vmcnt(0)" ::: "memory");
    __syncthreads();
    if (tid == 0) {
        unsigned* bar = b.bar;
        __builtin_amdgcn_s_waitcnt(0);
        unsigned nloc = b.st[0], nx = b.st[1];
        if (nloc == 0u) { xcd_barrier_complete(bar, b.x, G, nloc, nx); b.st[0] = nloc; b.st[1] = nx; }
        const unsigned old = xb_add(&bar[XB_XSUB(b.x)], 1u);
        const unsigned gen = old / nloc;
        if (old + 1u == (gen + 1u) * nloc) {
            __builtin_amdgcn_fence(__ATOMIC_RELEASE, "agent");
            asm volatile("s_waitcnt vmcnt(0)" ::: "memory");
            const unsigned og = xb_add(&bar[XB_TOP], 1u);
            const unsigned tg = og / nx;
            if (og + 1u == (tg + 1u) * nx) xb_add(&bar[XB_TOPGEN], 1u);
            else XB_SPIN(xb_ld(&bar[XB_TOPGEN]) == tg, bar);
            __builtin_amdgcn_fence(__ATOMIC_ACQUIRE, "agent");
            xb_add(&bar[XB_XGEN(b.x)], 1u);
            asm volatile("s_waitcnt vmcnt(0)" ::: "memory");
        } else {
            XB_SPIN(xb_ld(&bar[XB_XGEN(b.x)]) == gen, bar);
            __builtin_amdgcn_fence(__ATOMIC_ACQUIRE, "agent");
            asm volatile("s_waitcnt vmcnt(0)" ::: "memory");
        }
    }
    __syncthreads();
}

namespace pg8 {
constexpr int BM = 256, BK = 64, HALF = 128, HTB = HALF * BK * 2, NXCD = 8, WGM = 8;
__device__ __forceinline__ int lds_byte(int r, int c) { const int st = (r >> 4) * 2 + (c >> 5), rr = r & 15, cc = c & 31, ob = rr * 64 + cc * 2; return st * 1024 + (ob ^ (((ob >> 9) & 1) << 5)); }
__device__ __forceinline__ void stage_rc(int b, int& R, int& C) { const int st = b / 1024, sb = b % 1024, swz = sb ^ (((sb >> 9) & 1) << 5); R = (st >> 1) * 16 + swz / 64; C = (st & 1) * 32 + (swz % 64) / 2; }
__device__ __forceinline__ int perm32(int rho) { const int n = rho >> 4, i = rho & 15; return 8 * (i >> 2) + 4 * n + (i & 3); }

struct Unit { int pm, pn; };
struct Gemm { const bf16_t* A; const bf16_t* Bt; int M, N, K; };

struct StaticOrder {
    int nM, nN, nwg, G, c;
    __device__ void init(int M, int N, int G_, int c_) { nM = M / BM; nN = N / BM; nwg = nM * nN; G = G_; c = c_; }
    __device__ bool next(int i, Unit& u) const {
        const long L = (long)i * G + c; if (L >= nwg) return false;
        int wgid = (int)L; { const int q = nwg / NXCD, r = nwg % NXCD, xcd = wgid % NXCD, off = wgid / NXCD; wgid = (xcd < r ? xcd * (q + 1) : r * (q + 1) + (xcd - r) * q) + off; }
        const int nig = WGM * nN, gid = wgid / nig, fm = gid * WGM, gsz = (nM - fm) < WGM ? (nM - fm) : WGM;
        u.pm = fm + ((wgid % nig) % gsz); u.pn = (wgid % nig) / gsz; return true;
    }
    __device__ __forceinline__ void a_ready(const Unit&) const {}
    __device__ __forceinline__ void done(const Unit&) const {}
};
struct KvOrder {
    int G, c;
    __device__ bool next(int i, Unit& u) const { const int L = i * G + c; if (L >= 256) return false; u.pm = L >> 3; u.pn = ((u.pm >> 4) << 3) + (L & 7); return true; }
    __device__ __forceinline__ void a_ready(const Unit&) const {}
    __device__ __forceinline__ void done(const Unit&) const {}
};

struct EpiBf16 {
    static constexpr bool PERM = true;
    bf16_t* O; int ldc; const float* rs;
    __device__ __forceinline__ void prefetch(const Unit&, int, int, int, int) const {}
    __device__ __forceinline__ void operator()(const f32x4 (&acc)[2][2][4][2], const Unit& u, int wr, int wc, int fr, int fq, int) const {
        asm volatile("" : "+v"(fr), "+v"(fq));
        const int row0 = u.pm * BM + wr * 64 + fr, col0 = u.pn * BM + wc * 64 + 8 * fq;
#pragma unroll
        for (int ai = 0; ai < 2; ++ai)
#pragma unroll
            for (int m = 0; m < 4; ++m) { bf16_t* rowp = O + (size_t)(row0 + ai * HALF + m * 16) * ldc + col0;
                const float sc = rs ? rs[row0 + ai * HALF + m * 16] : 1.0f;
#pragma unroll
                for (int bj = 0; bj < 2; ++bj) { const f32x4 v0 = acc[ai][bj][m][0] * sc, v1 = acc[ai][bj][m][1] * sc;
                    u32x4 w; w.x = cvt_pk_bf16(v0[0], v0[1]); w.y = cvt_pk_bf16(v0[2], v0[3]); w.z = cvt_pk_bf16(v1[0], v1[1]); w.w = cvt_pk_bf16(v1[2], v1[3]);
                    *(u32x4*)(rowp + bj * 32) = w; } }
    }
};
struct EpiKV {
    static constexpr bool PERM = false;
    float* outk; float* outv; bf16_t* KP; bf16_t* VPT;
    __device__ __forceinline__ void prefetch(const Unit&, int, int, int, int) const {}
    __device__ __forceinline__ void operator()(const f32x4 (&acc)[2][2][4][2], const Unit& u, int wr, int wc, int fr, int fq, int) const {
        asm volatile("" : "+v"(fr), "+v"(fq));
        const int isv = (u.pn >> 2) & 1, h = u.pn & 3;
        float* C = isv ? outv : outk;
        const int row0 = wr * 64 + fr, col0 = wc * 64 + 4 * fq;
#pragma unroll
        for (int ai = 0; ai < 2; ++ai)
#pragma unroll
            for (int m = 0; m < 4; ++m) { const int r = row0 + ai * HALF + m * 16; const size_t grow = (size_t)u.pm * BM + r;
#pragma unroll
                for (int bj = 0; bj < 2; ++bj)
#pragma unroll
                    for (int n = 0; n < 2; ++n) { const int e = col0 + bj * 32 + n * 16; const f32x4 v = acc[ai][bj][m][n];
                        __builtin_nontemporal_store(v, (f32x4*)(C + grow * 1024 + h * 256 + e));
                        if (!isv) { u32x2 w; w.x = cvt_pk_bf16(v[0], v[1]); w.y = cvt_pk_bf16(v[2], v[3]); *(u32x2*)(KP + grow * 1024 + h * 256 + e) = w; }
                        else { u32x2 w; w.x = cvt_pk_bf16(v[0], v[1]); w.y = cvt_pk_bf16(v[2], v[3]); *(u32x2*)(VPT + grow * 1024 + h * 256 + e) = w; } } }
    }
};
struct EpiUp {
    static constexpr bool PERM = true;
    bf16_t* ACT; bf16_t* RAW; const float* cw; const float* cb; float* outp; float* outs; const float* rs; LAS unsigned char* xl;
    __device__ __forceinline__ void prefetch(const Unit& u, int par, int wr, int wc, int lane) const {
        LAS float* tb = (LAS float*)(xl + LDS_XTRA + (par * 8 + wr * 4 + wc) * 1536);
        const int L = lane, half = L >> 5, ff = u.pn * 128 + wc * 32 + (L & 31);
#pragma unroll
        for (int i = 0; i < 4; ++i) { const int a = 2 * i + half;
            const float* sp = (a == 3 ? cb : (a == 7 ? cb + DFF : cw + (a & 3) * NUP + (a >> 2) * DFF)) + ff;
            __builtin_amdgcn_global_load_lds((const unsigned*)sp, (LAS unsigned*)(tb + i * 64), 4, 0, 0); }
#pragma unroll
        for (int i = 0; i < 2; ++i) __builtin_amdgcn_global_load_lds((const unsigned*)(rs + u.pm * BM + i * HALF + wr * 64 + L), (LAS unsigned*)(tb + 256 + i * 64), 4, 0, 0);
    }
    __device__ __forceinline__ void operator()(f32x4 (&acc)[2][2][4][2], const Unit& u, int wr, int wc, int fr, int fq, int par) const {
        asm volatile("" : "+v"(fr), "+v"(fq));
        typedef float f32x2 __attribute__((ext_vector_type(2)));
        const int f0 = u.pn * 128 + wc * 32 + 8 * fq;
        const int Rb = u.pm * BM + wr * 64 + fr;
        LAS float* tb = (LAS float*)(xl + LDS_XTRA + (par * 8 + wr * 4 + wc) * 1536);
#pragma unroll
        for (int ai = 0; ai < 2; ++ai)
#pragma unroll
            for (int m = 0; m < 4; ++m) { const float sc = tb[256 + ai * 64 + m * 16 + fr];
#pragma unroll
                for (int bj = 0; bj < 2; ++bj)
#pragma unroll
                    for (int n = 0; n < 2; ++n) acc[ai][bj][m][n] *= sc; }
        f32x2 W[2][8];
#define EPIUP_LOADW(slot, it) do { const int fo_ = 8 * fq + 4 * ((it) >> 1) + 2 * ((it) & 1); _Pragma("unroll") for (int a_ = 0; a_ < 8; ++a_) W[slot][a_] = *(const LAS f32x2*)(tb + a_ * 32 + fo_); } while (0)
        EPIUP_LOADW(0, 0);
        unsigned pk[2][4][4];
#pragma unroll
        for (int it = 0; it < 4; ++it) {
            __builtin_amdgcn_sched_barrier(0);
            const int n = it >> 1, jp = it & 1, sl = it & 1;
            if (it < 3) EPIUP_LOADW(sl ^ 1, it + 1);
#pragma unroll
            for (int ai = 0; ai < 2; ++ai) {
#pragma unroll
                for (int m = 0; m < 4; ++m) {
                    f32x2 xg, xv, g1, g2, v1, v2;
#pragma unroll
                    for (int jj = 0; jj < 2; ++jj) {
                        const int j = 2 * jp + jj;
                        xg[jj] = acc[ai][0][m][n][j]; xv[jj] = acc[ai][1][m][n][j];
                        const float pg = m ? acc[ai][0][m ? m - 1 : 0][n][j] : 0.f, pv = m ? acc[ai][1][m ? m - 1 : 0][n][j] : 0.f;
                        g1[jj] = row_shift<1>(pg, xg[jj]); g2[jj] = row_shift<2>(pg, xg[jj]); v1[jj] = row_shift<1>(pv, xv[jj]); v2[jj] = row_shift<2>(pv, xv[jj]);
                    }
                    const f32x2 cg_ = W[sl][0] * g2 + W[sl][1] * g1 + W[sl][2] * xg + W[sl][3];
                    const f32x2 cv_ = W[sl][4] * v2 + W[sl][5] * v1 + W[sl][6] * xv + W[sl][7];
                    pk[ai][m][it] = cvt_pk_bf16(silu_f(cg_[0]) * cv_[0], silu_f(cg_[1]) * cv_[1]);
                }
            }
        }
        __builtin_amdgcn_sched_barrier(0);
#pragma unroll
        for (int ai = 0; ai < 2; ++ai)
#pragma unroll
            for (int m = 0; m < 4; ++m) { u32x4 w; w.x = pk[ai][m][0]; w.y = pk[ai][m][1]; w.z = pk[ai][m][2]; w.w = pk[ai][m][3];
                *(u32x4*)((char*)ACT + ((unsigned)(Rb + ai * HALF + m * 16) * (unsigned)DFF + (unsigned)f0) * 2u) = w; }
#undef EPIUP_LOADW
        __builtin_amdgcn_sched_barrier(0);
#pragma unroll
        for (int ai = 0; ai < 2; ++ai)
#pragma unroll
            for (int m = 0; m < 4; ++m) {
                const bool lo = ((m & 1) == 0) && fr < 2, hi = ((m & 1) == 1) && fr >= 14;
                if ((lo || hi) && (m == 0 || m == 3 || u.pm >= MP / BM)) {
                    const int R = Rb + ai * HALF + m * 16;
                    const int slot = lo ? 2 + fr : fr - 14;
                    bf16_t* rb = RAW + ((size_t)(R >> 5) * 4 + slot) * NUP + f0;
                    float* dst = nullptr;
                    if (hi) { if (R < MP) { if ((R & 2047) >= 2046) dst = outp + ((size_t)(R >> 11) * 2 + ((R & 2047) - 2046)) * NUP + f0; }
                              else dst = outs + ((size_t)((R - MP) >> 5) * 2 + ((R & 31) - 30)) * NUP + f0; }
#pragma unroll
                    for (int n = 0; n < 2; ++n) {
                        const f32x4 xg = acc[ai][0][m][n], xv = acc[ai][1][m][n];
                        u32x2 w; w.x = cvt_pk_bf16(xg[0], xg[1]); w.y = cvt_pk_bf16(xg[2], xg[3]); *(u32x2*)(rb + 4 * n) = w;
                        w.x = cvt_pk_bf16(xv[0], xv[1]); w.y = cvt_pk_bf16(xv[2], xv[3]); *(u32x2*)(rb + DFF + 4 * n) = w;
                        if (dst) { *(f32x4*)(dst + 4 * n) = xg; *(f32x4*)(dst + DFF + 4 * n) = xv; }
                    }
                }
            }
    }
};

template <class Epi, class Sched>
__device__ __forceinline__ void gemm_phase(LAS unsigned char* lds, const Gemm g, const Sched& S, const Epi& E, const int tid) {
    const int wid = __builtin_amdgcn_readfirstlane(tid >> 6), lane = tid & 63, wr = wid >> 2, wc = wid & 3, fr = lane & 15, fq = lane >> 4;
    const int K = g.K, nt = K / BK;
    unsigned voffA[2], voffB[2];
#pragma unroll
    for (int i = 0; i < 2; ++i) { int R, C; stage_rc(tid * 16 + i * 8192, R, C); const int Rb = (R >> 5) * 64 + (Epi::PERM ? perm32(R & 31) : (R & 31));
        voffA[i] = (unsigned)(R * K + C) * 2u; voffB[i] = (unsigned)(Rb * K + C) * 2u; }
    const size_t kstep = (size_t)(BK * 2);
    const size_t hstep = (size_t)HALF * K * 2;
    const size_t tstep = 2 * hstep;
    const size_t hstepB = (size_t)32 * K * 2;
    const unsigned ldsw = (unsigned)wid * 1024u;
    const int aoff = lds_byte(wr * 64 + fr, fq * 8), boff = lds_byte(wc * 32 + fr, fq * 8);
#define PG8_SA(b, h) (((b) * 2 + (h)) * HTB)
#define PG8_SB(b, h) ((4 + (b) * 2 + (h)) * HTB)
#define PG8_STAGE(bufoff, gbase, voff) do { _Pragma("unroll") for (int _i = 0; _i < 2; ++_i) \
        __builtin_amdgcn_global_load_lds((const unsigned*)((const char*)(gbase) + (voff)[_i]), (LAS unsigned*)(lds + (bufoff) + ldsw + _i * 8192), 16, 0, 0); } while (0)
#define PG8_LDA(dst, b, h) do { _Pragma("unroll") for (int m = 0; m < 4; ++m) _Pragma("unroll") for (int k = 0; k < 2; ++k) dst[m][k] = *(const LAS bf16x8*)(lds + PG8_SA(b, h) + aoff + m * 2048 + k * 1024); } while (0)
#define PG8_LDB(dst, b, h) do { _Pragma("unroll") for (int n = 0; n < 2; ++n) _Pragma("unroll") for (int k = 0; k < 2; ++k) dst[n][k] = *(const LAS bf16x8*)(lds + PG8_SB(b, h) + boff + n * 2048 + k * 1024); } while (0)
#define PG8_MMA(ai, bj, At, Bt) do { __builtin_amdgcn_s_setprio(1); _Pragma("unroll") for (int m = 0; m < 4; ++m) _Pragma("unroll") for (int n = 0; n < 2; ++n) _Pragma("unroll") for (int k = 0; k < 2; ++k) \
        acc[ai][bj][m][n] = __builtin_amdgcn_mfma_f32_16x16x32_bf16(Bt[n][k], At[m][k], acc[ai][bj][m][n], 0, 0, 0); __builtin_amdgcn_s_setprio(0); } while (0)
#define PG8_WAIT_V(n) asm volatile("s_waitcnt vmcnt(" #n ")" ::: "memory")
#define PG8_WAIT_L(n) asm volatile("s_waitcnt lgkmcnt(" #n ")" ::: "memory")
#define PG8_BAR __builtin_amdgcn_s_barrier()
#define PG8_SCHED __builtin_amdgcn_sched_barrier(0)
    Unit cur, nxt; int ui = 0;
    if (!S.next(0, cur)) return;
    f32x4 acc[2][2][4][2];
#pragma unroll
    for (int a = 0; a < 2; ++a)
#pragma unroll
        for (int b = 0; b < 2; ++b)
#pragma unroll
            for (int m = 0; m < 4; ++m)
#pragma unroll
                for (int n = 0; n < 2; ++n) acc[a][b][m][n] = (f32x4){0.f, 0.f, 0.f, 0.f};
    bf16x8 At[4][2], B0[2][2], B1[2][2];
    const char* cA = (const char*)g.A + (size_t)cur.pm * tstep; const char* cB = (const char*)g.Bt + (size_t)cur.pn * tstep;
    S.a_ready(cur); E.prefetch(cur, 0, wr, wc, lane);
    PG8_STAGE(PG8_SB(0, 0), cB, voffB); PG8_STAGE(PG8_SA(0, 0), cA, voffA); PG8_STAGE(PG8_SB(0, 1), cB + hstepB, voffB); PG8_STAGE(PG8_SA(0, 1), cA + hstep, voffA);
    if (wr == 1) PG8_BAR;
    PG8_WAIT_V(4); PG8_BAR;
    PG8_STAGE(PG8_SB(1, 0), cB + kstep, voffB); PG8_STAGE(PG8_SA(1, 0), cA + kstep, voffA); PG8_STAGE(PG8_SB(1, 1), cB + hstepB + kstep, voffB);
    PG8_WAIT_V(6); PG8_BAR;
    for (;;) {
        const bool has_next = S.next(ui + 1, nxt);
        const char* nA = has_next ? (const char*)g.A + (size_t)nxt.pm * tstep : cA; const char* nB = has_next ? (const char*)g.Bt + (size_t)nxt.pn * tstep : cB;
        for (int t = 0; t < nt; t += 2) {
            const bool last = (t == nt - 2);
            const char* a1 = cA + (size_t)(t + 1) * kstep;
            const char* a2 = last ? nA : cA + (size_t)(t + 2) * kstep; const char* b2 = last ? nB : cB + (size_t)(t + 2) * kstep;
            const char* a3 = a2 + kstep; const char* b3 = b2 + kstep;
            if (last && has_next) { S.a_ready(nxt); E.prefetch(nxt, (ui + 1) & 1, wr, wc, lane); }
            PG8_LDB(B0, 0, 0); PG8_SCHED; PG8_LDA(At, 0, 0); PG8_STAGE(PG8_SA(1, 1), a1 + hstep, voffA);
            PG8_WAIT_L(8); PG8_BAR; PG8_WAIT_L(0); PG8_MMA(0, 0, At, B0); PG8_BAR; PG8_SCHED;
            PG8_LDB(B1, 0, 1); PG8_STAGE(PG8_SB(0, 0), b2, voffB);
            PG8_BAR; PG8_WAIT_L(0); PG8_MMA(0, 1, At, B1); PG8_BAR;
            PG8_LDA(At, 0, 1); PG8_STAGE(PG8_SA(0, 0), a2, voffA);
            PG8_BAR; PG8_WAIT_L(0); PG8_MMA(1, 0, At, B0); PG8_BAR; PG8_SCHED;
            PG8_STAGE(PG8_SB(0, 1), b2 + hstepB, voffB);
            PG8_WAIT_V(6); PG8_BAR; PG8_MMA(1, 1, At, B1); PG8_BAR;
            PG8_LDB(B0, 1, 0); PG8_SCHED; PG8_LDA(At, 1, 0); PG8_STAGE(PG8_SA(0, 1), a2 + hstep, voffA);
            PG8_WAIT_L(8); PG8_BAR; PG8_WAIT_L(0); PG8_MMA(0, 0, At, B0); PG8_BAR; PG8_SCHED;
            PG8_LDB(B1, 1, 1); PG8_STAGE(PG8_SB(1, 0), b3, voffB);
            PG8_BAR; PG8_WAIT_L(0); PG8_MMA(0, 1, At, B1); PG8_BAR;
            PG8_LDA(At, 1, 1); PG8_STAGE(PG8_SA(1, 0), a3, voffA);
            PG8_BAR; PG8_WAIT_L(0); PG8_MMA(1, 0, At, B0); PG8_BAR; PG8_SCHED;
            PG8_STAGE(PG8_SB(1, 1), b3 + hstepB, voffB);
            PG8_WAIT_V(6); PG8_BAR; PG8_MMA(1, 1, At, B1); PG8_BAR;
        }
        E(acc, cur, wr, wc, fr, fq, ui & 1); S.done(cur);
        if (!has_next) break;
#pragma unroll
        for (int a = 0; a < 2; ++a)
#pragma unroll
            for (int b = 0; b < 2; ++b)
#pragma unroll
                for (int m = 0; m < 4; ++m)
#pragma unroll
                    for (int n = 0; n < 2; ++n) acc[a][b][m][n] = (f32x4){0.f, 0.f, 0.f, 0.f};
        cur = nxt; cA = nA; cB = nB; ++ui;
    }
    PG8_WAIT_V(0);
    if (wr == 0) PG8_BAR;
    PG8_BAR;
#undef PG8_SA
#undef PG8_SB
#undef PG8_STAGE
#undef PG8_LDA
#undef PG8_LDB
#undef PG8_MMA
#undef PG8_WAIT_V
#undef PG8_WAIT_L
#undef PG8_BAR
#undef PG8_SCHED
}
}


__device__ __forceinline__ void small_gemm(LAS unsigned char* lds, const bf16_t* A, const bf16_t* Bt, int N, int K, bf16_t* O, int ldc, const float* rs, int bid, int G, int tid, int wid, int lane) {
    const int fr = lane & 15, fq = lane >> 4, kq = wid >> 1, rh = wid & 1;
    const int nct = N >> 6, nunits = 16 * nct, kslice = K >> 2, nks = kslice >> 5;
    LAS float* P = (LAS float*)lds;
    for (int u = bid; u < nunits; u += G) {
        const int rt = u / nct, ct = u - rt * nct;
        const bf16_t* ap = A + (size_t)(MP + rt * 64 + rh * 32 + fr) * K + kq * kslice + fq * 8;
        const bf16_t* bp = Bt + (size_t)(ct * 64 + fr) * K + kq * kslice + fq * 8;
        f32x4 acc[2][4];
#pragma unroll
        for (int rb = 0; rb < 2; ++rb)
#pragma unroll
            for (int cb = 0; cb < 4; ++cb) acc[rb][cb] = (f32x4){0.f, 0.f, 0.f, 0.f};
        for (int c0 = 0; c0 < nks; c0 += 4) {
            bf16x8 a[4][2], b[4][4];
#pragma unroll
            for (int i = 0; i < 4; ++i) { const int ks = (c0 + i < nks) ? c0 + i : nks - 1;
#pragma unroll
                for (int rb = 0; rb < 2; ++rb) a[i][rb] = *(const bf16x8*)(ap + (size_t)rb * 16 * K + ks * 32);
#pragma unroll
                for (int cb = 0; cb < 4; ++cb) b[i][cb] = *(const bf16x8*)(bp + (size_t)cb * 16 * K + ks * 32); }
            __builtin_amdgcn_sched_barrier(0);
#pragma unroll
            for (int i = 0; i < 4; ++i) { if (c0 + i < nks) {
#pragma unroll
                for (int rb = 0; rb < 2; ++rb)
#pragma unroll
                    for (int cb = 0; cb < 4; ++cb) acc[rb][cb] = __builtin_amdgcn_mfma_f32_16x16x32_bf16(b[i][cb], a[i][rb], acc[rb][cb], 0, 0, 0); } }
            __builtin_amdgcn_sched_barrier(0);
        }
#pragma unroll
        for (int rb = 0; rb < 2; ++rb)
#pragma unroll
            for (int cb = 0; cb < 4; ++cb) *(LAS f32x4*)(P + (kq * 64 + rh * 32 + rb * 16 + fr) * 68 + cb * 16 + fq * 4) = acc[rb][cb];
        __syncthreads();
        { const int row = tid >> 3, c8 = (tid & 7) * 8; float f[8];
          f32x4 s0 = *(const LAS f32x4*)(P + row * 68 + c8), s1 = *(const LAS f32x4*)(P + row * 68 + c8 + 4);
#pragma unroll
          for (int q = 1; q < 4; ++q) { s0 += *(const LAS f32x4*)(P + (q * 64 + row) * 68 + c8); s1 += *(const LAS f32x4*)(P + (q * 64 + row) * 68 + c8 + 4); }
          const float sc = rs ? rs[MP + rt * 64 + row] : 1.0f; s0 *= sc; s1 *= sc;
          f[0] = s0[0]; f[1] = s0[1]; f[2] = s0[2]; f[3] = s0[3]; f[4] = s1[0]; f[5] = s1[1]; f[6] = s1[2]; f[7] = s1[3];
          *(u32x4*)(O + (size_t)(MP + rt * 64 + row) * ldc + ct * 64 + c8) = pack8(f); }
        __syncthreads();
    }
}

__device__ __forceinline__ void convert_cache(const float* ck, const float* cv, bf16_t* KC, bf16_t* VCT, LAS unsigned char* lds, int bid, int G, int tid, int gtid, int nthr) {
    for (int i = gtid; i < 32 * 256 * 1024 / 8; i += nthr) {
        const f32x4 a = __builtin_nontemporal_load((const f32x4*)(ck + (size_t)i * 8)), b = __builtin_nontemporal_load((const f32x4*)(ck + (size_t)i * 8 + 4));
        u32x4 w; w.x = cvt_pk_bf16(a[0], a[1]); w.y = cvt_pk_bf16(a[2], a[3]); w.z = cvt_pk_bf16(b[0], b[1]); w.w = cvt_pk_bf16(b[2], b[3]);
        __builtin_nontemporal_store(w, (u32x4*)(KC + (size_t)i * 8));
    }
    { LAS float* T = (LAS float*)lds;
      for (int tile = bid; tile < 32 * 4 * 16; tile += G) {
        const int s = tile >> 6, h = (tile >> 4) & 3, r0 = ((tile >> 2) & 3) * 64, e0 = (tile & 3) * 64;
        { const int rr = tid >> 3, ec = (tid & 7) * 8; const float* sp = cv + ((size_t)(s * 256 + r0 + rr) * 4 + h) * 256 + e0 + ec;
          const f32x4 a = __builtin_nontemporal_load((const f32x4*)sp), b = __builtin_nontemporal_load((const f32x4*)(sp + 4));
          LAS float* tp = T + rr * 65 + ec; tp[0] = a[0]; tp[1] = a[1]; tp[2] = a[2]; tp[3] = a[3]; tp[4] = b[0]; tp[5] = b[1]; tp[6] = b[2]; tp[7] = b[3]; }
        __syncthreads();
        { const int ee = tid >> 3, rc = (tid & 7) * 8; float f[8];
#pragma unroll
          for (int i = 0; i < 8; ++i) f[i] = T[(rc + i) * 65 + ee];
          __builtin_nontemporal_store(pack8(f), (u32x4*)(VCT + ((size_t)(s * 4 + h) * 256 + e0 + ee) * 256 + r0 + rc)); }
        __syncthreads();
      } }
}

__device__ __forceinline__ void weight_tile(PP pp, bf16_t* W, bf16_t* WKV, LAS float* T, int l, int tl, int tid) {
        const float* src; bf16_t* dst; const float* gfold = nullptr; int K, N, t, upmap = 0;
        if (tl < 512) { src = pp->in[I_WIN] + (size_t)l * 1024 * 2048; K = 1024; N = 2048; dst = W + l * WL_ELEMS + WL_WIN; t = tl; gfold = pp->in[I_GMIXPRE] + l * 1024; }
        else if (tl < 768) { src = pp->in[I_WOUT] + (size_t)l * 1048576; K = 1024; N = 1024; dst = W + l * WL_ELEMS + WL_WOUT; t = tl - 512; }
        else if (tl < 1024) { src = pp->in[I_WQ] + (size_t)l * 1048576; K = 1024; N = 1024; dst = W + l * WL_ELEMS + WL_WQ; t = tl - 768; gfold = pp->in[I_GATTPRE] + l * 1024; }
        else if (tl < 1280) { src = pp->in[I_WO] + (size_t)l * 1048576; K = 1024; N = 1024; dst = W + l * WL_ELEMS + WL_WO; t = tl - 1024; }
        else if (tl < 2688) { src = pp->in[I_WUP] + (size_t)l * 1024 * NUP; K = 1024; N = NUP; dst = W + l * WL_ELEMS + WL_WUP; t = tl - 1280; upmap = 1; gfold = pp->in[I_GFFNPRE] + l * 1024; }
        else if (tl < 3392) { src = pp->in[I_WDOWN] + (size_t)l * DFF * 1024; K = DFF; N = 1024; dst = W + l * WL_ELEMS + WL_WDOWN; t = tl - 2688; }
        else if (tl < 3648) { src = pp->in[I_WK] + (size_t)l * 1048576; K = 1024; N = 1024; dst = WKV + (size_t)(l * 2048) * 1024; t = tl - 3392; }
        else { src = pp->in[I_WV] + (size_t)l * 1048576; K = 1024; N = 1024; dst = WKV + (size_t)(l * 2048 + 1024) * 1024; t = tl - 3648; }
        const int ntn = N >> 6, tk = t / ntn, tn = t % ntn, k0 = tk * 64, n0 = tn * 64;
        { const int kr = tid >> 3, nc = (tid & 7) * 8; const float* sp = src + (size_t)(k0 + kr) * N + n0 + nc;
          const float gk = gfold ? gfold[k0 + kr] : 1.0f;
          const f32x4 a = __builtin_nontemporal_load((const f32x4*)sp) * gk, b = __builtin_nontemporal_load((const f32x4*)(sp + 4)) * gk;
          LAS float* tp = T + kr * 65 + nc; tp[0] = a[0]; tp[1] = a[1]; tp[2] = a[2]; tp[3] = a[3]; tp[4] = b[0]; tp[5] = b[1]; tp[6] = b[2]; tp[7] = b[3]; }
        __syncthreads();
        { const int nr = tid >> 3, kc = (tid & 7) * 8; float f[8];
#pragma unroll
          for (int i = 0; i < 8; ++i) f[i] = T[(kc + i) * 65 + nr];
          int n = n0 + nr;
          if (upmap) { const int bj = n >= DFF ? 1 : 0, ff = n - bj * DFF; n = ((ff >> 7) << 8) + (((ff & 127) >> 5) << 6) + (bj << 5) + (ff & 31); }
          *(u32x4*)(dst + (size_t)n * K + k0 + kc) = pack8(f); }
        __syncthreads();
}
__device__ __forceinline__ void pool_weight_chunk(PP pp, bf16_t* W, int l, int i) {
    const int n = (i >> 6) & 511, kc = (i & 63) * 8, g = n >> 7; float f[8];
    const float sc = pp->in[I_PSCALE][l * 512 + n];
#pragma unroll
    for (int k = 0; k < 8; ++k) { const int kk = kc + k; f[k] = ((kk >> 7) == g) ? pp->in[I_WPOOL][(((size_t)l * 4 + g) * 128 + (kk & 127)) * 128 + (n & 127)] * sc : 0.f; }
    *(u32x4*)(W + l * WL_ELEMS + WL_POOL + (size_t)n * 512 + kc) = pack8(f);
}
__device__ __forceinline__ void deferred_weights(PP pp, LAS unsigned char* lds, int l, int tl0, int tl1, bool pool, int rank, int nrank, int tid) {
    bf16_t* W = (bf16_t*)(pp->ws + WS_W); bf16_t* WKV = (bf16_t*)(pp->ws + WS_WKV);
    LAS float* T = (LAS float*)lds;
    for (int tl = tl0 + rank; tl < tl1; tl += nrank) weight_tile(pp, W, WKV, T, l, tl, tid);
    if (pool) for (int i = rank * 512 + tid; i < 512 * 64; i += nrank * 512) pool_weight_chunk(pp, W, l, i);
}
__device__ __forceinline__ void prep_phase(PP pp, LAS unsigned char* lds, int bid, int G, int tid, int wid, int lane) {
    bf16_t* W = (bf16_t*)(pp->ws + WS_W); bf16_t* WKV = (bf16_t*)(pp->ws + WS_WKV);
    LAS float* T = (LAS float*)lds;
    for (int t2 = bid; t2 < 512 + 512 + 512; t2 += G) { if (t2 < 512) weight_tile(pp, W, WKV, T, 0, t2, tid); else if (t2 < 1024) weight_tile(pp, W, WKV, T, 0, 3392 + (t2 - 512), tid); else weight_tile(pp, W, WKV, T, 1, 3392 + (t2 - 1024), tid); }
    const int gtid = bid * 512 + tid, nthr = G * 512, gwave = bid * 8 + wid, nwaves = G * 8;
    for (int i = gtid; i < 512 * 64; i += nthr) pool_weight_chunk(pp, W, 0, i);
    { bf16_t* XB = (bf16_t*)(pp->ws + WS_H); float* RS = (float*)(pp->ws + WS_RS);
      for (int r = gwave; r < MT; r += nwaves) {
        const float* xr = r < MP ? pp->in[I_XP] + (size_t)r * 1024 : pp->in[I_XS] + (size_t)(r - MP) * 1024;
        f32x4 x[4]; float ss = 0.f;
#pragma unroll
        for (int i = 0; i < 4; ++i) { x[i] = __builtin_nontemporal_load((const f32x4*)(xr + i * 256 + lane * 4)); ss += x[i][0] * x[i][0] + x[i][1] * x[i][1] + x[i][2] * x[i][2] + x[i][3] * x[i][3]; }
        ss = wave_sum(ss, lane);
        if (lane == 0) RS[r] = rsqrtf(ss * (1.0f / 1024.0f) + 1e-6f);
#pragma unroll
        for (int i = 0; i < 4; ++i) { u32x2 w; w.x = cvt_pk_bf16(x[i][0], x[i][1]); w.y = cvt_pk_bf16(x[i][2], x[i][3]);
            *(u32x2*)(XB + (size_t)r * 1024 + i * 256 + lane * 4) = w; }
      } }
    { bf16_t* MEMN = (bf16_t*)(pp->ws + WS_MEMN);
      for (int r = gwave; r < 4096; r += nwaves) {
        const float* xr = pp->in[I_MEM] + (size_t)r * 1024; f32x4 x[4]; float ss = 0.f;
#pragma unroll
        for (int i = 0; i < 4; ++i) { x[i] = __builtin_nontemporal_load((const f32x4*)(xr + i * 256 + lane * 4)); ss += x[i][0] * x[i][0] + x[i][1] * x[i][1] + x[i][2] * x[i][2] + x[i][3] * x[i][3]; }
        ss = wave_sum(ss, lane); const float rs = rsqrtf(ss * (1.0f / 1024.0f) + 1e-6f);
#pragma unroll
        for (int l = 0; l < 2; ++l)
#pragma unroll
            for (int i = 0; i < 4; ++i) { const f32x4 g = *(const f32x4*)(pp->in[I_GMEM] + l * 1024 + i * 256 + lane * 4);
                u32x2 w; w.x = cvt_pk_bf16(x[i][0] * rs * g[0], x[i][1] * rs * g[1]); w.y = cvt_pk_bf16(x[i][2] * rs * g[2], x[i][3] * rs * g[3]);
                *(u32x2*)(MEMN + ((size_t)l * 4096 + r) * 1024 + i * 256 + lane * 4) = w; }
      } }
    convert_cache(pp->in[I_CK], pp->in[I_CV], (bf16_t*)(pp->ws + WS_KC), (bf16_t*)(pp->ws + WS_VCT), lds, bid, G, tid, gtid, nthr);
}

template <bool FAST> __device__ __forceinline__ void mix_load_u(const bf16_t* PROJ, const float* hist15, bool prompt, int Rr, int tt, int f0, float* u) {
    if (FAST || tt >= 0) unpack8(*(const u32x4*)(PROJ + (size_t)Rr * 2048 + f0), u);
    else if (!prompt) { const float* hp = hist15 + (size_t)(15 + tt) * 512 + f0; const f32x4 a = *(const f32x4*)hp, b = *(const f32x4*)(hp + 4);
        u[0] = a[0]; u[1] = a[1]; u[2] = a[2]; u[3] = a[3]; u[4] = b[0]; u[5] = b[1]; u[6] = b[2]; u[7] = b[3]; }
    else {
#pragma unroll
        for (int q = 0; q < 8; ++q) u[q] = 0.f; }
}
template <bool FAST> __device__ __forceinline__ void mixer_run(const bf16_t* PROJ, LAS unsigned char* DL, bf16_t* YCAT, const float* hist15, const float* hist2, float* pool_out, float* conv_out,
                                                                const float (&cw0)[8], const float (&cw1)[8], const float (&cw2)[8], const float (&cbv)[8],
                                                                bool prompt, int R0, int t0, int nrows, int T, int lane) {
    const int f0 = lane * 8, w = 2 << (lane >> 4);
    float S[8];
#pragma unroll
    for (int q = 0; q < 8; ++q) S[q] = 0.f;
    for (int k = 1; k < 16; ++k) {
        if (k < w) { float u[8]; mix_load_u<FAST>(PROJ, hist15, prompt, R0 - k, t0 - k, f0, u);
#pragma unroll
            for (int q = 0; q < 8; ++q) S[q] += u[q]; }
    }
    float cv1[8], cv2[8];
#pragma unroll
    for (int hh = 1; hh <= 2; ++hh) {
        const int tt = t0 - hh; float x[8];
        if (FAST || tt >= 0) { float c[8], v[8]; const bf16_t* pr = PROJ + (size_t)(R0 - hh) * 2048 + f0; unpack8(*(const u32x4*)(pr + 1024), c); unpack8(*(const u32x4*)(pr + 1536), v);
#pragma unroll
            for (int q = 0; q < 8; ++q) x[q] = c[q] * v[q]; }
        else if (!prompt) { const float* hp = hist2 + (size_t)(2 + tt) * 512 + f0;
#pragma unroll
            for (int q = 0; q < 8; ++q) x[q] = hp[q]; }
        else {
#pragma unroll
            for (int q = 0; q < 8; ++q) x[q] = 0.f; }
#pragma unroll
        for (int q = 0; q < 8; ++q) { if (hh == 1) cv1[q] = x[q]; else cv2[q] = x[q]; }
    }
    for (int i0 = 0; i0 < nrows; i0 += 4) {
        float un[4][8], uo[4][8]; u32x4 lb[4], lc[4], lv[4];
#pragma unroll
        for (int r = 0; r < 4; ++r) {
            const int R = R0 + i0 + r, t = t0 + i0 + r; const bf16_t* pr = PROJ + (size_t)R * 2048 + f0;
            unpack8(*(const u32x4*)pr, un[r]);
            mix_load_u<FAST>(PROJ, hist15, prompt, R - w + 1, t - w + 1, f0, uo[r]);
            lb[r] = *(const u32x4*)(pr + 512); lc[r] = *(const u32x4*)(pr + 1024); lv[r] = *(const u32x4*)(pr + 1536);
        }
#pragma unroll
        for (int r = 0; r < 4; ++r) {
            const int R = R0 + i0 + r, t = t0 + i0 + r;
            const int cnt = (FAST || !prompt) ? w : (w < t + 1 ? w : t + 1); const float ic = 1.0f / (float)cnt;
            float d[8];
#pragma unroll
            for (int q = 0; q < 8; ++q) { S[q] += un[r][q]; d[q] = S[q] * ic - un[r][q]; S[q] -= uo[r][q]; }
            *(LAS u32x4*)(DL + (i0 + r) * DT_PITCH + f0 * 2) = pack8(d);
            if (t >= T - 15) { float* pn = pool_out + (size_t)(t - (T - 15)) * 512 + f0;
                *(f32x4*)pn = (f32x4){un[r][0], un[r][1], un[r][2], un[r][3]}; *(f32x4*)(pn + 4) = (f32x4){un[r][4], un[r][5], un[r][6], un[r][7]}; }
            float b[8], c[8], v[8], cv0[8], yb[8];
            unpack8(lb[r], b); unpack8(lc[r], c); unpack8(lv[r], v);
#pragma unroll
            for (int q = 0; q < 8; ++q) { cv0[q] = c[q] * v[q]; yb[q] = b[q] * (cw0[q] * cv2[q] + cw1[q] * cv1[q] + cw2[q] * cv0[q] + cbv[q]); }
            *(u32x4*)(YCAT + (size_t)R * 1024 + 512 + f0) = pack8(yb);
            if (t >= T - 2) { float* cn = conv_out + (size_t)(t - (T - 2)) * 512 + f0;
                *(f32x4*)cn = (f32x4){cv0[0], cv0[1], cv0[2], cv0[3]}; *(f32x4*)(cn + 4) = (f32x4){cv0[4], cv0[5], cv0[6], cv0[7]}; }
#pragma unroll
            for (int q = 0; q < 8; ++q) { cv2[q] = cv1[q]; cv1[q] = cv0[q]; }
        }
    }
}
__device__ __forceinline__ void transpose_vrow(const bf16_t* VROW, bf16_t* VPT, LAS unsigned char* lds, int bid, int G, int tid) {
    LAS float* T = (LAS float*)lds;
    for (int tile = bid; tile < 32 * 4 * 16; tile += G) {
        const int ls = tile >> 6, h = (tile >> 4) & 3, r0 = ((tile >> 2) & 3) * 64, e0 = (tile & 3) * 64;
        { const int rr = tid >> 3, ec = (tid & 7) * 8; float f[8]; unpack8(*(const u32x4*)(VROW + (size_t)(ls * 256 + r0 + rr) * 1024 + h * 256 + e0 + ec), f);
          LAS float* tp = T + rr * 65 + ec;
#pragma unroll
          for (int i = 0; i < 8; ++i) tp[i] = f[i]; }
        __syncthreads();
        { const int ee = tid >> 3, rc = (tid & 7) * 8; float f[8];
#pragma unroll
          for (int i = 0; i < 8; ++i) f[i] = T[(rc + i) * 65 + ee];
          *(u32x4*)(VPT + ((size_t)(ls * 4 + h) * 256 + e0 + ee) * 256 + r0 + rc) = pack8(f); }
        __syncthreads();
    }
}
__device__ __forceinline__ void mixer_phase(PP pp, LAS unsigned char* lds, int l, int bid, int G, int wid, int lane) {
    const bf16_t* PROJ = (const bf16_t*)(pp->ws + BIG_PROJ); bf16_t* YCAT = (bf16_t*)(pp->ws + BIG_YCAT);
    const float* spool = pp->in[I_SPOOL] + (size_t)l * 32 * 15 * 512; const float* sconv = pp->in[I_SCONV] + (size_t)l * 32 * 2 * 512;
    float* opp = pp->out + O_POOLP + (size_t)l * 16 * 15 * 512; float* ops = pp->out + O_POOLS + (size_t)l * 32 * 15 * 512;
    float* ocp = pp->out + O_CONVP + (size_t)l * 16 * 2 * 512; float* ocs = pp->out + O_CONVS + (size_t)l * 32 * 2 * 512;
    const int f0 = lane * 8, fr = lane & 15, fq = lane >> 4;
    float cw0[8], cw1[8], cw2[8], cbv[8];
    { const float* cwp = pp->in[I_CONVW] + (size_t)l * 3 * 512; const float* cbp = pp->in[I_CONVB] + (size_t)l * 512;
#pragma unroll
      for (int k = 0; k < 8; ++k) { cw0[k] = cwp[f0 + k]; cw1[k] = cwp[512 + f0 + k]; cw2[k] = cwp[1024 + f0 + k]; cbv[k] = cbp[f0 + k]; } }
    const bf16_t* PT = (const bf16_t*)(pp->ws + WS_W) + (size_t)l * WL_ELEMS + WL_POOL;
    if (l == 0) transpose_vrow((const bf16_t*)(pp->ws + WS_VROW), (bf16_t*)(pp->ws + WS_VPT), lds, bid, G, wid * 64 + lane);
    const int g = wid >> 1, nh = wid & 1;
    for (int task = bid; task < 256 + 32; task += G) {
        const bool prompt = task < 256; const int rpw = prompt ? 16 : 4;
        const int R0 = prompt ? task * 128 : MP + (task - 256) * 32;
        const int Rw = R0 + wid * rpw;
        LAS unsigned char* DL = lds + wid * rpw * DT_PITCH;
        if (prompt) { const int s = Rw >> 11, t0 = Rw & 2047;
            if (t0 >= 16) mixer_run<true>(PROJ, DL, YCAT, spool, sconv, opp + (size_t)s * 15 * 512, ocp + (size_t)s * 2 * 512, cw0, cw1, cw2, cbv, true, Rw, t0, 16, 2048, lane);
            else mixer_run<false>(PROJ, DL, YCAT, spool, sconv, opp + (size_t)s * 15 * 512, ocp + (size_t)s * 2 * 512, cw0, cw1, cw2, cbv, true, Rw, t0, 16, 2048, lane);
        } else { const int s = (Rw - MP) >> 5, t0 = Rw & 31;
            mixer_run<false>(PROJ, DL, YCAT, spool + (size_t)s * 15 * 512, sconv + (size_t)s * 2 * 512, ops + (size_t)s * 15 * 512, ocs + (size_t)s * 2 * 512, cw0, cw1, cw2, cbv, false, Rw, t0, 4, 32, lane); }
        bf16x8 A[4][4];
#pragma unroll
        for (int nb = 0; nb < 4; ++nb)
#pragma unroll
            for (int ks = 0; ks < 4; ++ks) A[nb][ks] = *(const bf16x8*)(PT + (size_t)(g * 128 + nh * 64 + nb * 16 + fr) * 512 + g * 128 + ks * 32 + fq * 8);
        __syncthreads();
        const int nrb = prompt ? 8 : 2;
        for (int rb = 0; rb < nrb; ++rb) {
            bf16x8 B[4];
#pragma unroll
            for (int ks = 0; ks < 4; ++ks) B[ks] = *(const LAS bf16x8*)(lds + (rb * 16 + fr) * DT_PITCH + (g * 128 + ks * 32 + fq * 8) * 2);
#pragma unroll
            for (int nb = 0; nb < 4; ++nb) {
                f32x4 a = (f32x4){0.f, 0.f, 0.f, 0.f};
#pragma unroll
                for (int ks = 0; ks < 4; ++ks) a = __builtin_amdgcn_mfma_f32_16x16x32_bf16(A[nb][ks], B[ks], a, 0, 0, 0);
                u32x2 w; w.x = cvt_pk_bf16(a[0], a[1]); w.y = cvt_pk_bf16(a[2], a[3]);
                *(u32x2*)(YCAT + (size_t)(R0 + rb * 16 + fr) * 1024 + g * 128 + nh * 64 + nb * 16 + fq * 4) = w;
            }
        }
        __syncthreads();
    }
    if (l == 0) {
        const int nsec = 288 - G;
        if (nsec <= 0 || nsec >= G) deferred_weights(pp, lds, 0, 512, 3392, false, bid, G, wid * 64 + lane);
        else if (bid >= nsec) deferred_weights(pp, lds, 0, 512, 3392, false, bid - nsec, G - nsec, wid * 64 + lane);
    }
}

__device__ __forceinline__ void resnorm_phase(const bf16_t* Y, bf16_t* XB, float* RS, const float* gpost, float* OUT, int gwave, int nwaves, int lane) {
    f32x4 g[4];
#pragma unroll
    for (int i = 0; i < 4; ++i) g[i] = *(const f32x4*)(gpost + i * 256 + lane * 4);
    for (int r0 = gwave * 2; r0 < MT; r0 += nwaves * 2) {
        f32x4 x[2][4], y[2][4]; float ss[2] = {0.f, 0.f};
#pragma unroll
        for (int k = 0; k < 2; ++k)
#pragma unroll
            for (int i = 0; i < 4; ++i) { const size_t o = (size_t)(r0 + k) * 1024 + i * 256 + lane * 4;
                const u32x2 w = __builtin_nontemporal_load((const u32x2*)(Y + o)); y[k][i] = (f32x4){bf_lo(w.x), bf_hi(w.x), bf_lo(w.y), bf_hi(w.y)};
                const u32x2 v = *(const u32x2*)(XB + o); x[k][i] = (f32x4){bf_lo(v.x), bf_hi(v.x), bf_lo(v.y), bf_hi(v.y)}; }
#pragma unroll
        for (int k = 0; k < 2; ++k)
#pragma unroll
            for (int i = 0; i < 4; ++i) ss[k] += y[k][i][0] * y[k][i][0] + y[k][i][1] * y[k][i][1] + y[k][i][2] * y[k][i][2] + y[k][i][3] * y[k][i][3];
#pragma unroll
        for (int o = 32; o >= 1; o >>= 1) { ss[0] += shfl_xor_l(ss[0], o, lane); ss[1] += shfl_xor_l(ss[1], o, lane); }
        float s2[2] = {0.f, 0.f};
#pragma unroll
        for (int k = 0; k < 2; ++k) { const float rs = rsqrtf(ss[k] * (1.0f / 1024.0f) + 1e-6f);
#pragma unroll
            for (int i = 0; i < 4; ++i) { x[k][i] = x[k][i] + (y[k][i] * rs) * g[i];
                s2[k] += x[k][i][0] * x[k][i][0] + x[k][i][1] * x[k][i][1] + x[k][i][2] * x[k][i][2] + x[k][i][3] * x[k][i][3]; } }
        if (OUT) {
#pragma unroll
            for (int k = 0; k < 2; ++k)
#pragma unroll
                for (int i = 0; i < 4; ++i) __builtin_nontemporal_store(x[k][i], (f32x4*)(OUT + (size_t)(r0 + k) * 1024 + i * 256 + lane * 4));
        } else {
#pragma unroll
            for (int o = 32; o >= 1; o >>= 1) { s2[0] += shfl_xor_l(s2[0], o, lane); s2[1] += shfl_xor_l(s2[1], o, lane); }
            if (lane < 2) RS[r0 + lane] = rsqrtf((lane ? s2[1] : s2[0]) * (1.0f / 1024.0f) + 1e-6f);
#pragma unroll
            for (int k = 0; k < 2; ++k)
#pragma unroll
                for (int i = 0; i < 4; ++i) { u32x2 w; w.x = cvt_pk_bf16(x[k][i][0], x[k][i][1]); w.y = cvt_pk_bf16(x[k][i][2], x[k][i][3]);
                    *(u32x2*)(XB + (size_t)(r0 + k) * 1024 + i * 256 + lane * 4) = w; }
        }
    }
}

__device__ __forceinline__ void softmax_to_p(f32x4 (&sacc)[16], bf16x8 (&pf)[8], int lane) {
    float mx = -3.0e38f;
#pragma unroll
    for (int kb = 0; kb < 16; ++kb)
#pragma unroll
        for (int j = 0; j < 4; ++j) mx = fmaxf(mx, sacc[kb][j]);
    mx = fmaxf(mx, shfl_xor_l(mx, 16, lane)); mx = fmaxf(mx, shfl_xor_l(mx, 32, lane));
    float sum = 0.f; const float c = 0.0625f * 1.44269504f;
#pragma unroll
    for (int kb = 0; kb < 16; ++kb)
#pragma unroll
        for (int j = 0; j < 4; ++j) { const float e = __builtin_amdgcn_exp2f((sacc[kb][j] - mx) * c); sacc[kb][j] = e; sum += e; }
    sum += shfl_xor_l(sum, 16, lane); sum += shfl_xor_l(sum, 32, lane);
    const float inv = 1.0f / sum;
#pragma unroll
    for (int kk = 0; kk < 8; ++kk) { u32x4 w; w.x = cvt_pk_bf16(sacc[2 * kk][0] * inv, sacc[2 * kk][1] * inv); w.y = cvt_pk_bf16(sacc[2 * kk][2] * inv, sacc[2 * kk][3] * inv);
        w.z = cvt_pk_bf16(sacc[2 * kk + 1][0] * inv, sacc[2 * kk + 1][1] * inv); w.w = cvt_pk_bf16(sacc[2 * kk + 1][2] * inv, sacc[2 * kk + 1][3] * inv);
        pf[kk] = __builtin_bit_cast(bf16x8, w); }
}
__device__ __forceinline__ void attn_phase(LAS unsigned char* lds, const bf16_t* Q, bf16_t* O, const bf16_t* KPl, const bf16_t* VPTl, const bf16_t* KC, const bf16_t* VCT, int bid, int G, int tid, int wid, int lane) {
    const int fr = lane & 15, fq = lane >> 4;
    unsigned voffK[2], voffV[2];
#pragma unroll
    for (int i = 0; i < 2; ++i) { int R, C; pg8::stage_rc(tid * 16 + i * 8192, R, C); voffK[i] = (unsigned)(((R & ~31) + pg8::perm32(R & 31)) * 1024 + C) * 2u; voffV[i] = (unsigned)(R * 256 + C) * 2u; }
    const unsigned ldsw = (unsigned)wid * 1024u;
    const int koff = pg8::lds_byte(fr, fq * 8);
    for (int i = 0; i * G + bid < 512 + 128; ++i) {
        const int lin = i * G + bid;
        int h, R0; bool active; const bf16_t* Kb; const bf16_t* Vt;
        if (lin < 512) {
            int sh, qi;
            if ((G & 7) == 0 && G <= 512 && (512 % G) == 0) { const int x = bid & 7, j = (bid >> 3) + (G >> 3) * i; sh = x * 8 + (j >> 3); qi = j & 7; }
            else { sh = lin >> 3; qi = lin & 7; }
            const int s = sh >> 2; h = sh & 3; R0 = s * 2048 + qi * 256 + wid * 32; active = true;
            Kb = KPl + (size_t)s * 262144 + h * 256; Vt = VPTl + (size_t)(s * 4 + h) * 65536;
        } else {
            const int j = lin - 512, s = j >> 2; h = j & 3; R0 = MP + s * 32; active = (wid == 0);
            Kb = KC + (size_t)s * 262144 + h * 256; Vt = VCT + (size_t)(s * 4 + h) * 65536;
        }
#pragma unroll
        for (int c = 0; c < 4; ++c)
#pragma unroll
            for (int hh = 0; hh < 2; ++hh)
#pragma unroll
                for (int q = 0; q < 2; ++q)
                    __builtin_amdgcn_global_load_lds((const unsigned*)((const char*)(Kb + (size_t)hh * 128 * 1024 + c * 64) + voffK[q]), (LAS unsigned*)(lds + (c * 2 + hh) * pg8::HTB + ldsw + q * 8192), 16, 0, 0);
        const bf16_t* qp = Q + (size_t)(R0 + fr) * 1024 + h * 256 + fq * 8;
        bf16x8 qa[2], qb[2];
        qa[0] = *(const bf16x8*)(qp); qb[0] = *(const bf16x8*)(qp + 16 * 1024);
        asm volatile("s_waitcnt vmcnt(2)" ::: "memory");
        __syncthreads();
        f32x4 s0[16], s1[16];
#pragma unroll
        for (int kb = 0; kb < 16; ++kb) { s0[kb] = (f32x4){0.f, 0.f, 0.f, 0.f}; s1[kb] = (f32x4){0.f, 0.f, 0.f, 0.f}; }
        bf16x8 p0[8], p1[8];
        if (active) {
#pragma unroll
        for (int ks = 0; ks < 8; ++ks) {
            __builtin_amdgcn_sched_barrier(0);
            if (ks + 1 < 8) { qa[(ks + 1) % 2] = *(const bf16x8*)(qp + (ks + 1) * 32); qb[(ks + 1) % 2] = *(const bf16x8*)(qp + 16 * 1024 + (ks + 1) * 32); }
#pragma unroll
            for (int kb = 0; kb < 16; ++kb) {
                const bf16x8 kf = *(const LAS bf16x8*)(lds + ((ks >> 1) * 2 + (kb >> 3)) * pg8::HTB + koff + (kb & 7) * 2048 + (ks & 1) * 1024);
                s0[kb] = __builtin_amdgcn_mfma_f32_16x16x32_bf16(kf, qa[ks % 2], s0[kb], 0, 0, 0);
                s1[kb] = __builtin_amdgcn_mfma_f32_16x16x32_bf16(kf, qb[ks % 2], s1[kb], 0, 0, 0);
            }
        }
        __builtin_amdgcn_sched_barrier(0);
        softmax_to_p(s0, p0, lane); softmax_to_p(s1, p1, lane);
        }
        __syncthreads();
#pragma unroll
        for (int c = 0; c < 4; ++c)
#pragma unroll
            for (int hh = 0; hh < 2; ++hh)
#pragma unroll
                for (int q = 0; q < 2; ++q)
                    __builtin_amdgcn_global_load_lds((const unsigned*)((const char*)(Vt + (size_t)hh * 128 * 256 + c * 64) + voffV[q]), (LAS unsigned*)(lds + (c * 2 + hh) * pg8::HTB + ldsw + q * 8192), 16, 0, 0);
        asm volatile("s_waitcnt vmcnt(0)" ::: "memory");
        __syncthreads();
        if (active) {
        int fr2 = fr, fq2 = fq; asm volatile("" : "+v"(fr2), "+v"(fq2));
        const int koff2 = pg8::lds_byte(fr2, fq2 * 8);
#pragma unroll
        for (int dg = 0; dg < 4; ++dg) {
            __builtin_amdgcn_sched_barrier(0);
            f32x4 a0[4], a1[4];
#pragma unroll
            for (int d = 0; d < 4; ++d) { a0[d] = (f32x4){0.f, 0.f, 0.f, 0.f}; a1[d] = (f32x4){0.f, 0.f, 0.f, 0.f}; }
#pragma unroll
            for (int kk = 0; kk < 8; ++kk)
#pragma unroll
                for (int d = 0; d < 4; ++d) {
                    const int db = dg * 4 + d;
                    const bf16x8 vf = *(const LAS bf16x8*)(lds + ((kk >> 1) * 2 + (db >> 3)) * pg8::HTB + koff2 + (db & 7) * 2048 + (kk & 1) * 1024);
                    a0[d] = __builtin_amdgcn_mfma_f32_16x16x32_bf16(vf, p0[kk], a0[d], 0, 0, 0);
                    a1[d] = __builtin_amdgcn_mfma_f32_16x16x32_bf16(vf, p1[kk], a1[d], 0, 0, 0);
                }
#pragma unroll
            for (int d = 0; d < 4; ++d) { const int db = dg * 4 + d;
                u32x2 w; w.x = cvt_pk_bf16(a0[d][0], a0[d][1]); w.y = cvt_pk_bf16(a0[d][2], a0[d][3]);
                *(u32x2*)(O + (size_t)(R0 + fr2) * 1024 + h * 256 + db * 16 + fq2 * 4) = w;
                w.x = cvt_pk_bf16(a1[d][0], a1[d][1]); w.y = cvt_pk_bf16(a1[d][2], a1[d][3]);
                *(u32x2*)(O + (size_t)(R0 + 16 + fr2) * 1024 + h * 256 + db * 16 + fq2 * 4) = w; }
        }
        }
        __syncthreads();
    }
}

__device__ __forceinline__ void load_raw8(const bf16_t* RAW, const float* hist, int blk, int slot, int hidx, bool use_hist, bool zero, int col, float* f) {
    if (zero) {
#pragma unroll
        for (int q = 0; q < 8; ++q) f[q] = 0.f; }
    else if (use_hist) { const float* hp = hist + (size_t)hidx * NUP + col; const f32x4 a = *(const f32x4*)hp, b = *(const f32x4*)(hp + 4);
        f[0] = a[0]; f[1] = a[1]; f[2] = a[2]; f[3] = a[3]; f[4] = b[0]; f[5] = b[1]; f[6] = b[2]; f[7] = b[3]; }
    else unpack8(*(const u32x4*)(RAW + ((size_t)blk * 4 + slot) * NUP + col), f);
}
__device__ __forceinline__ void fixup_phase(PP pp, int l, int gtid, int nthr) {
    const bf16_t* RAW = (const bf16_t*)(pp->ws + BIG_RAW); bf16_t* ACT = (bf16_t*)(pp->ws + BIG_ACT);
    const float* cw = pp->in[I_FCW] + (size_t)l * 3 * NUP; const float* cb = pp->in[I_FCB] + (size_t)l * NUP;
    const float* sffn = pp->in[I_SFFN] + (size_t)l * 32 * 2 * NUP;
    for (int idx = gtid; idx < (MP / 32 + (MT - MP) / 16) * 352; idx += nthr) {
        const int rowi = idx / 352, ch = idx % 352, q = rowi & 1, blk = rowi < MP / 32 ? (rowi >> 1) * 2 : MP / 32 + ((rowi - MP / 32) >> 1), R = blk * 32 + q, f0 = ch * 8;
        const bool prompt = R < MP; const int t = prompt ? (R & 2047) : q;
        const float* hist = prompt ? sffn : sffn + (size_t)((R - MP) >> 5) * 2 * NUP;
        float act[8], cg[8], cvv[8];
#pragma unroll
        for (int part = 0; part < 2; ++part) {
            const int col = part * DFF + f0; float x0[8], x1[8], x2[8];
            load_raw8(RAW, hist, blk, 2 + q, 0, false, false, col, x0);
            { const bool in = (t - 1) >= 0; load_raw8(RAW, hist, q ? blk : blk - 1, q ? 2 : 1, 1, !in, !in && prompt, col, x1); }
            { const bool in = (t - 2) >= 0; load_raw8(RAW, hist, blk - 1, q ? 1 : 0, q ? 1 : 0, !in, !in && prompt, col, x2); }
            const f32x4 w0a = *(const f32x4*)(cw + col), w0b = *(const f32x4*)(cw + col + 4), w1a = *(const f32x4*)(cw + NUP + col), w1b = *(const f32x4*)(cw + NUP + col + 4),
                        w2a = *(const f32x4*)(cw + 2 * NUP + col), w2b = *(const f32x4*)(cw + 2 * NUP + col + 4), ba = *(const f32x4*)(cb + col), bb = *(const f32x4*)(cb + col + 4);
#pragma unroll
            for (int k = 0; k < 8; ++k) { const float w0 = k < 4 ? w0a[k & 3] : w0b[k & 3], w1 = k < 4 ? w1a[k & 3] : w1b[k & 3], w2 = k < 4 ? w2a[k & 3] : w2b[k & 3], bbv = k < 4 ? ba[k & 3] : bb[k & 3];
                const float z = w0 * x2[k] + w1 * x1[k] + w2 * x0[k] + bbv; if (part == 0) cg[k] = z; else cvv[k] = z; }
        }
#pragma unroll
        for (int k = 0; k < 8; ++k) act[k] = silu_f(cg[k]) * cvv[k];
        *(u32x4*)(ACT + (size_t)R * DFF + f0) = pack8(act);
    }
}

#ifndef DBG_NSTEP
#define DBG_NSTEP (2 + 13 * 2)
#endif
constexpr int NSTEP = DBG_NSTEP;
__global__ void __launch_bounds__(512, 2) mega(Params p_) {
    extern __shared__ __attribute__((aligned(16))) unsigned char shm[];
    LAS unsigned char* lds = (LAS unsigned char*)shm;
    cg::grid_group grid = cg::this_grid();
    { volatile LAS unsigned* st = (volatile LAS unsigned*)(lds + LDS_ST);
      int t0 = threadIdx.x; PP p0 = (PP)__builtin_amdgcn_kernarg_segment_ptr();
      if (t0 < 4) st[t0] = 0u;
      __syncthreads();
      (void)xcd_barrier_post((unsigned*)(p0->ws + WS_CTL), st, t0); }

    int tid = threadIdx.x, G = gridDim.x, bid = blockIdx.x;
    for (int step = 0; step < NSTEP; ++step) {
        asm volatile("" : "+v"(tid));
        asm volatile("" : "+s"(G), "+s"(bid));
        const __attribute__((address_space(4))) Params* pp = (const __attribute__((address_space(4))) Params*)__builtin_amdgcn_kernarg_segment_ptr();
        asm volatile("" : "+s"(pp));
        const int lane = tid & 63, wid = __builtin_amdgcn_readfirstlane(tid >> 6);
        const int gtid = bid * 512 + tid, nthr = G * 512, gwave = bid * 8 + wid, nwaves = G * 8;
        bf16_t* XB = (bf16_t*)(pp->ws + WS_H); bf16_t* Y = (bf16_t*)(pp->ws + WS_Y);
        float* RS = (float*)(pp->ws + WS_RS);
        if (step == 0) { prep_phase(pp, lds, bid, G, tid, wid, lane); }
        else if (step == 1) {
            pg8::Gemm g{(const bf16_t*)(pp->ws + WS_MEMN), (const bf16_t*)(pp->ws + WS_WKV), 8192, 4096, 1024};
            pg8::KvOrder S{G, bid};
            pg8::EpiKV E{pp->out + O_MK, pp->out + O_MV, (bf16_t*)(pp->ws + WS_KP), (bf16_t*)(pp->ws + WS_VROW)};
            pg8::gemm_phase<pg8::EpiKV, pg8::KvOrder>(lds, g, S, E, tid);
        } else {
            const int l = (step - 2) / 13, k = (step - 2) % 13;
            const bf16_t* WL = (const bf16_t*)(pp->ws + WS_W) + (size_t)l * WL_ELEMS;
            bool is_gemm = false; pg8::Gemm g{nullptr, nullptr, MT, 1024, 1024}; pg8::EpiBf16 E{nullptr, 1024, nullptr};
            switch (k) {
            case 0: g = pg8::Gemm{XB, WL + WL_WIN, MT, 2048, 1024}; E = pg8::EpiBf16{(bf16_t*)(pp->ws + BIG_PROJ), 2048, RS}; is_gemm = true; break;
            case 1: mixer_phase(pp, lds, l, bid, G, wid, lane); break;
            case 2: break;
            case 3: g = pg8::Gemm{(const bf16_t*)(pp->ws + BIG_YCAT), WL + WL_WOUT, MT, 1024, 1024}; E = pg8::EpiBf16{Y, 1024, nullptr}; is_gemm = true; break;
            case 4: resnorm_phase(Y, XB, RS, pp->in[I_GMIXPOST] + l * 1024, nullptr, gwave, nwaves, lane); break;
            case 5: g = pg8::Gemm{XB, WL + WL_WQ, MT, 1024, 1024}; E = pg8::EpiBf16{(bf16_t*)(pp->ws + BIG_Q), 1024, RS}; is_gemm = true; break;
            case 6: attn_phase(lds, (const bf16_t*)(pp->ws + BIG_Q), (bf16_t*)(pp->ws + BIG_O), (const bf16_t*)(pp->ws + WS_KP) + (size_t)l * 4096 * 1024, (const bf16_t*)(pp->ws + WS_VPT) + (size_t)l * 4096 * 1024,
                               (const bf16_t*)(pp->ws + WS_KC), (const bf16_t*)(pp->ws + WS_VCT), bid, G, tid, wid, lane); break;
            case 7: g = pg8::Gemm{(const bf16_t*)(pp->ws + BIG_O), WL + WL_WO, MT, 1024, 1024}; E = pg8::EpiBf16{Y, 1024, nullptr}; is_gemm = true; break;
            case 8: resnorm_phase(Y, XB, RS, pp->in[I_GATTPOST] + l * 1024, nullptr, gwave, nwaves, lane);
                    if (l == 0) convert_cache(pp->in[I_CK] + (size_t)32 * 256 * 1024, pp->in[I_CV] + (size_t)32 * 256 * 1024, (bf16_t*)(pp->ws + WS_KC), (bf16_t*)(pp->ws + WS_VCT), lds, bid, G, tid, gtid, nthr);
                    break;
            case 9: {
                pg8::Gemm gu{XB, WL + WL_WUP, MT, NUP, 1024}; pg8::StaticOrder S; S.init(MT, NUP, G, bid);
                pg8::EpiUp EU{(bf16_t*)(pp->ws + BIG_ACT), (bf16_t*)(pp->ws + BIG_RAW), pp->in[I_FCW] + (size_t)l * 3 * NUP, pp->in[I_FCB] + (size_t)l * NUP,
                              pp->out + O_FFNP + (size_t)l * 16 * 2 * NUP, pp->out + O_FFNS + (size_t)l * 32 * 2 * NUP, RS, lds};
                pg8::gemm_phase<pg8::EpiUp, pg8::StaticOrder>(lds, gu, S, EU, tid);
                if (l == 0) {
                    const int rem = S.nwg % G;
                    if (rem == 0) deferred_weights(pp, lds, 1, 0, 3392, true, bid, G, tid);
                    else if (bid >= rem) deferred_weights(pp, lds, 1, 0, 3392, true, bid - rem, G - rem, tid);
                }
            } break;
            case 10: fixup_phase(pp, l, gtid, nthr); break;
            case 11: g = pg8::Gemm{(const bf16_t*)(pp->ws + BIG_ACT), WL + WL_WDOWN, MT, 1024, DFF}; E = pg8::EpiBf16{Y, 1024, nullptr}; is_gemm = true; break;
            case 12: resnorm_phase(Y, XB, RS, pp->in[I_GFFNPOST] + l * 1024, l == 1 ? pp->out + O_Y : nullptr, gwave, nwaves, lane); break;
            }
            if (is_gemm) {
                pg8::StaticOrder S; S.init(MP, g.N, G, bid); pg8::gemm_phase<pg8::EpiBf16, pg8::StaticOrder>(lds, g, S, E, tid);
                small_gemm(lds, g.A, g.Bt, g.N, g.K, E.O, E.ldc, E.rs, bid, G, tid, wid, lane);
            }
        }
        if (pp->ws == nullptr) grid.sync();
        if (step != 1 && !(step >= 2 && (step - 2) % 13 == 2) && step != NSTEP - 1) {
            XcdBarrier xb; xb.bar = (unsigned*)(pp->ws + WS_CTL); xb.x = xb_xcc_id(); xb.st = (volatile LAS unsigned*)(lds + LDS_ST);
            xcd_barrier(xb, tid, (unsigned)G);
        }
    }
}

extern "C" void kernel_launch(void* const* d_in, const int* in_sizes, int n_in, void* d_out, int out_size, void* d_ws, size_t ws_size, hipStream_t stream) {
    static int grid_blocks = 0;
    if (!grid_blocks) {
        int dev = 0, cus = 0, per_cu = 0;
        hipGetDevice(&dev);
        hipDeviceGetAttribute(&cus, hipDeviceAttributeMultiprocessorCount, dev);
        hipFuncSetAttribute((const void*)mega, hipFuncAttributeMaxDynamicSharedMemorySize, LDS_BYTES);
        hipOccupancyMaxActiveBlocksPerMultiprocessor(&per_cu, (const void*)mega, 512, LDS_BYTES);
        if (per_cu < 1) per_cu = 1;
        grid_blocks = cus * per_cu;
        if (ws_size < 500 * MiB) fprintf(stderr, "kernel_launch: workspace too small: %zu\n", ws_size);
    }
    Params p{};
    for (int i = 0; i < 29; ++i) p.in[i] = (const float*)d_in[i];
    p.out = (float*)d_out; p.ws = (unsigned char*)d_ws;
    (void)hipMemsetAsync((char*)d_ws + WS_CTL, 0, XCD_BAR_WORDS * 4, stream);
    void* args[] = {&p};
    hipError_t e = hipLaunchCooperativeKernel((const void*)mega, dim3(grid_blocks), dim3(512), args, LDS_BYTES, stream);
    if (e != hipSuccess) fprintf(stderr, "cooperative launch failed: %s (grid %d)\n", hipGetErrorString(e), grid_blocks);
}
```

```cpp
#include <hip/hip_runtime.h>
#include <hip/hip_cooperative_groups.h>
#include <cstdio>
namespace cg = cooperative_groups;

#define LAS __attribute__((address_space(3)))
typedef unsigned short bf16_t;
typedef short bf16x8 __attribute__((ext_vector_type(8)));
typedef float f32x4 __attribute__((ext_vector_type(4)));
typedef unsigned u32x4 __attribute__((ext_vector_type(4)));
typedef unsigned u32x2 __attribute__((ext_vector_type(2)));

constexpr int DM = 1024;
constexpr int MP = 32768;
constexpr int MT = 33792;
constexpr int NUP = 5632, DFF = 2816;
constexpr int LDS_XTRA = 131072 + 256;
constexpr int LDS_ST = LDS_XTRA + 16 * 1536;
constexpr int LDS_BYTES = LDS_ST + 16;
constexpr int DT_PITCH = 1040;

enum { I_XP = 0, I_XS, I_MEM, I_CK, I_CV, I_SPOOL, I_SCONV, I_SFFN, I_GMIXPRE, I_GMIXPOST, I_WIN, I_WPOOL, I_PSCALE, I_CONVW, I_CONVB,
       I_WOUT, I_GATTPRE, I_GATTPOST, I_GMEM, I_WQ, I_WK, I_WV, I_WO, I_GFFNPRE, I_GFFNPOST, I_WUP, I_FCW, I_FCB, I_WDOWN };

constexpr size_t O_Y = 0, O_MK = 34603008, O_MV = 42991616, O_POOLP = 51380224, O_CONVP = 51625984, O_FFNP = 51658752,
                 O_POOLS = 52019200, O_CONVS = 52510720, O_FFNS = 52576256;

constexpr size_t MiB = 1048576;
constexpr size_t WL_WIN = 0, WL_WOUT = 2097152, WL_WQ = 3145728, WL_WO = 4194304, WL_WUP = 5242880, WL_WDOWN = 11010048, WL_POOL = 13893632,
                 WL_ELEMS = 14155776;
constexpr size_t WS_W = 0, WS_KP = 54 * MiB, WS_VPT = 70 * MiB, WS_KC = 86 * MiB, WS_VCT = 102 * MiB, WS_H = 118 * MiB, WS_Y = 184 * MiB,
                 WS_BIG = 250 * MiB;
constexpr size_t WS_RS = 481 * MiB + 16384;
constexpr size_t WS_VROW = 484 * MiB;
constexpr size_t WS_CTL = 481 * MiB;
constexpr size_t WS_MEMN = WS_Y, WS_WKV = WS_Y + 16 * MiB;
constexpr size_t BIG_PROJ = WS_BIG, BIG_DD = WS_BIG + 132 * MiB, BIG_YCAT = WS_BIG + 165 * MiB;
constexpr size_t BIG_Q = WS_BIG, BIG_O = WS_BIG + 66 * MiB;
constexpr size_t BIG_ACT = WS_BIG, BIG_RAW = WS_BIG + 182 * MiB;

struct Params { const float* in[29]; float* out; unsigned char* ws; };
typedef const __attribute__((address_space(4))) Params* PP;

typedef __bf16 bf16x2_t __attribute__((ext_vector_type(2)));
typedef float f32x2_t __attribute__((ext_vector_type(2)));
__device__ __forceinline__ unsigned cvt_pk_bf16(float lo, float hi) { const f32x2_t v = {lo, hi}; const bf16x2_t b = __builtin_convertvector(v, bf16x2_t); return __builtin_bit_cast(unsigned, b); }
__device__ __forceinline__ float bf_lo(unsigned w) { return __uint_as_float(w << 16); }
__device__ __forceinline__ float bf_hi(unsigned w) { return __uint_as_float(w & 0xffff0000u); }
__device__ __forceinline__ void unpack8(const u32x4 w, float* f) {
    f[0] = bf_lo(w.x); f[1] = bf_hi(w.x); f[2] = bf_lo(w.y); f[3] = bf_hi(w.y); f[4] = bf_lo(w.z); f[5] = bf_hi(w.z); f[6] = bf_lo(w.w); f[7] = bf_hi(w.w); }
__device__ __forceinline__ u32x4 pack8(const float* f) { u32x4 w; w.x = cvt_pk_bf16(f[0], f[1]); w.y = cvt_pk_bf16(f[2], f[3]); w.z = cvt_pk_bf16(f[4], f[5]); w.w = cvt_pk_bf16(f[6], f[7]); return w; }
__device__ __forceinline__ float shfl_xor_l(float v, int o, int lane) { return __int_as_float(__builtin_amdgcn_ds_bpermute((lane ^ o) << 2, __float_as_int(v))); }
__device__ __forceinline__ float wave_sum(float v, int lane) { for (int o = 32; o >= 1; o >>= 1) v += shfl_xor_l(v, o, lane); return v; }
template <int K> __device__ __forceinline__ float row_shift(float prev, float cur) {
    int t = __builtin_amdgcn_mov_dpp(__float_as_int(prev), 0x100 + (16 - K), 0xf, 0xf, false);
    int r = __builtin_amdgcn_update_dpp(t, __float_as_int(cur), 0x110 + K, 0xf, 0xf, false);
    return __int_as_float(r);
}
__device__ __forceinline__ float silu_f(float z) { return z * __builtin_amdgcn_rcpf(1.0f + __builtin_amdgcn_exp2f(-1.44269504f * z)); }


#define XB_TMO      128
#define XB_XCNT(j)  (256  + 64 * (j))
#define XB_XSUB(j)  (1280 + 64 * (j))
#define XB_XGEN(j)  (2304 + 64 * (j))
#define XB_TOP      3328
#define XB_TOPGEN   3392
#define XCD_BAR_WORDS 3456
#define XB_SPIN_CAP (1u << 18)
__device__ __forceinline__ unsigned xb_ld(unsigned* p)              { return __hip_atomic_load(p, __ATOMIC_RELAXED, __HIP_MEMORY_SCOPE_AGENT); }
__device__ __forceinline__ unsigned xb_add(unsigned* p, unsigned v) { return __hip_atomic_fetch_add(p, v, __ATOMIC_RELAXED, __HIP_MEMORY_SCOPE_AGENT); }
__device__ __forceinline__ unsigned xb_xcc_id() { return (unsigned)__builtin_amdgcn_s_getreg((3 << 11) | 20) & 0xFu; }
#define XB_SPIN(cond, bar) do { unsigned _sp = 0; while (cond) { __builtin_amdgcn_s_sleep(1); \
    if ((++_sp & 255u) == 0u) { if (xb_ld(&(bar)[XB_TMO])) break; if (_sp > XB_SPIN_CAP) { atomicAdd(&(bar)[XB_TMO], 1u); break; } } } } while (0)
struct XcdBarrier { unsigned* bar; unsigned x; volatile LAS unsigned* st; };
__device__ __forceinline__ XcdBarrier xcd_barrier_post(unsigned* bar, volatile LAS unsigned* st, int tid) {
    XcdBarrier b; b.bar = bar; b.x = xb_xcc_id(); b.st = st;
    if (tid == 0) (void)xb_add(&bar[XB_XCNT(b.x)], 1u);
    return b;
}
__device__ __forceinline__ void xcd_barrier_complete(unsigned* bar, unsigned x, unsigned G, unsigned& nloc, unsigned& nx) {
    unsigned sum, cnt, mine, sp = 0u;
    for (;;) {
        sum = 0u; cnt = 0u; mine = 0u;
#pragma unroll
        for (unsigned j = 0; j < 16; ++j) { const unsigned c = xb_ld(&bar[XB_XCNT(j)]); sum += c; cnt += (c > 0u) ? 1u : 0u; mine = (j == x) ? c : mine; }
        if (sum == G) break;
        __builtin_amdgcn_s_sleep(1);
        if ((++sp & 255u) == 0u) { if (xb_ld(&bar[XB_TMO])) break; if (sp > XB_SPIN_CAP) { atomicAdd(&bar[XB_TMO], 1u); break; } }
    }
    nloc = mine > 0u ? mine : 1u; nx = cnt > 0u ? cnt : 1u;
}
__device__ __forceinline__ void xcd_barrier(const XcdBarrier& b, int tid, unsigned G) {
    asm volatile("s_waitcnt vmcnt(0)" ::: "memory");
    __syncthreads();
    if (tid == 0) {
        unsigned* bar = b.bar;
        __builtin_amdgcn_s_waitcnt(0);
        unsigned nloc = b.st[0], nx = b.st[1];
        if (nloc == 0u) { xcd_barrier_complete(bar, b.x, G, nloc, nx); b.st[0] = nloc; b.st[1] = nx; }
        const unsigned old = xb_add(&bar[XB_XSUB(b.x)], 1u);
        const unsigned gen = old / nloc;
        if (old + 1u == (gen + 1u) * nloc) {
            __builtin_amdgcn_fence(__ATOMIC_RELEASE, "agent");
            asm volatile("s_waitcnt vmcnt(0)" ::: "memory");
            const unsigned og = xb_add(&bar[XB_TOP], 1u);
            const unsigned tg = og / nx;
            if (og + 1u == (tg + 1u) * nx) xb_add(&bar[XB_TOPGEN], 1u);
            else XB_SPIN(xb_ld(&bar[XB_TOPGEN]) == tg, bar);
            __builtin_amdgcn_fence(__ATOMIC_ACQUIRE, "agent");
            xb_add(&bar[XB_XGEN(b.x)], 1u);
            asm volatile("s_waitcnt vmcnt(0)" ::: "memory");
        } else {
            XB_SPIN(xb_ld(&bar[XB_XGEN(b.x)]) == gen, bar);
            __builtin_amdgcn_fence(__ATOMIC_ACQUIRE, "agent");
            asm volatile("s_waitcnt vmcnt(0)" ::: "memory");
        }
    }
    __syncthreads();
}

namespace pg8 {
constexpr int BM = 256, BK = 64, HALF = 128, HTB = HALF * BK * 2, NXCD = 8, WGM = 8;
__device__ __forceinline__ int lds_byte(int r, int c) { const int st = (r >> 4) * 2 + (c >> 5), rr = r & 15, cc = c & 31, ob = rr * 64 + cc * 2; return st * 1024 + (ob ^ (((ob >> 9) & 1) << 5)); }
__device__ __forceinline__ void stage_rc(int b, int& R, int& C) { const int st = b / 1024, sb = b % 1024, swz = sb ^ (((sb >> 9) & 1) << 5); R = (st >> 1) * 16 + swz / 64; C = (st & 1) * 32 + (swz % 64) / 2; }
__device__ __forceinline__ int perm32(int rho) { const int n = rho >> 4, i = rho & 15; return 8 * (i >> 2) + 4 * n + (i & 3); }

struct Unit { int pm, pn; };
struct Gemm { const bf16_t* A; const bf16_t* Bt; int M, N, K; };

struct StaticOrder {
    int nM, nN, nwg, G, c;
    __device__ void init(int M, int N, int G_, int c_) { nM = M / BM; nN = N / BM; nwg = nM * nN; G = G_; c = c_; }
    __device__ bool next(int i, Unit& u) const {
        const long L = (long)i * G + c; if (L >= nwg) return false;
        int wgid = (int)L; { const int q = nwg / NXCD, r = nwg % NXCD, xcd = wgid % NXCD, off = wgid / NXCD; wgid = (xcd < r ? xcd * (q + 1) : r * (q + 1) + (xcd - r) * q) + off; }
        const int nig = WGM * nN, gid = wgid / nig, fm = gid * WGM, gsz = (nM - fm) < WGM ? (nM - fm) : WGM;
        u.pm = fm + ((wgid % nig) % gsz); u.pn = (wgid % nig) / gsz; return true;
    }
    __device__ __forceinline__ void a_ready(const Unit&) const {}
    __device__ __forceinline__ void done(const Unit&) const {}
};
struct KvOrder {
    int G, c;
    __device__ bool next(int i, Unit& u) const { const int L = i * G + c; if (L >= 256) return false; u.pm = L >> 3; u.pn = ((u.pm >> 4) << 3) + (L & 7); return true; }
    __device__ __forceinline__ void a_ready(const Unit&) const {}
    __device__ __forceinline__ void done(const Unit&) const {}
};

struct EpiBf16 {
    static constexpr bool PERM = true;
    bf16_t* O; int ldc; const float* rs;
    __device__ __forceinline__ void prefetch(const Unit&, int, int, int, int) const {}
    __device__ __forceinline__ void operator()(const f32x4 (&acc)[2][2][4][2], const Unit& u, int wr, int wc, int fr, int fq, int) const {
        asm volatile("" : "+v"(fr), "+v"(fq));
        const int row0 = u.pm * BM + wr * 64 + fr, col0 = u.pn * BM + wc * 64 + 8 * fq;
#pragma unroll
        for (int ai = 0; ai < 2; ++ai)
#pragma unroll
            for (int m = 0; m < 4; ++m) { bf16_t* rowp = O + (size_t)(row0 + ai * HALF + m * 16) * ldc + col0;
                const float sc = rs ? rs[row0 + ai * HALF + m * 16] : 1.0f;
#pragma unroll
                for (int bj = 0; bj < 2; ++bj) { const f32x4 v0 = acc[ai][bj][m][0] * sc, v1 = acc[ai][bj][m][1] * sc;
                    u32x4 w; w.x = cvt_pk_bf16(v0[0], v0[1]); w.y = cvt_pk_bf16(v0[2], v0[3]); w.z = cvt_pk_bf16(v1[0], v1[1]); w.w = cvt_pk_bf16(v1[2], v1[3]);
                    *(u32x4*)(rowp + bj * 32) = w; } }
    }
};
struct EpiKV {
    static constexpr bool PERM = false;
    float* outk; float* outv; bf16_t* KP; bf16_t* VPT;
    __device__ __forceinline__ void prefetch(const Unit&, int, int, int, int) const {}
    __device__ __forceinline__ void operator()(const f32x4 (&acc)[2][2][4][2], const Unit& u, int wr, int wc, int fr, int fq, int) const {
        asm volatile("" : "+v"(fr), "+v"(fq));
        const int isv = (u.pn >> 2) & 1, h = u.pn & 3;
        float* C = isv ? outv : outk;
        const int row0 = wr * 64 + fr, col0 = wc * 64 + 4 * fq;
#pragma unroll
        for (int ai = 0; ai < 2; ++ai)
#pragma unroll
            for (int m = 0; m < 4; ++m) { const int r = row0 + ai * HALF + m * 16; const size_t grow = (size_t)u.pm * BM + r;
#pragma unroll
                for (int bj = 0; bj < 2; ++bj)
#pragma unroll
                    for (int n = 0; n < 2; ++n) { const int e = col0 + bj * 32 + n * 16; const f32x4 v = acc[ai][bj][m][n];
                        __builtin_nontemporal_store(v, (f32x4*)(C + grow * 1024 + h * 256 + e));
                        if (!isv) { u32x2 w; w.x = cvt_pk_bf16(v[0], v[1]); w.y = cvt_pk_bf16(v[2], v[3]); *(u32x2*)(KP + grow * 1024 + h * 256 + e) = w; }
                        else { u32x2 w; w.x = cvt_pk_bf16(v[0], v[1]); w.y = cvt_pk_bf16(v[2], v[3]); *(u32x2*)(VPT + grow * 1024 + h * 256 + e) = w; } } }
    }
};
struct EpiUp {
    static constexpr bool PERM = true;
    bf16_t* ACT; bf16_t* RAW; const float* cw; const float* cb; float* outp; float* outs; const float* rs; LAS unsigned char* xl;
    __device__ __forceinline__ void prefetch(const Unit& u, int par, int wr, int wc, int lane) const {
        LAS float* tb = (LAS float*)(xl + LDS_XTRA + (par * 8 + wr * 4 + wc) * 1536);
        const int L = lane, half = L >> 5, ff = u.pn * 128 + wc * 32 + (L & 31);
#pragma unroll
        for (int i = 0; i < 4; ++i) { const int a = 2 * i + half;
            const float* sp = (a == 3 ? cb : (a == 7 ? cb + DFF : cw + (a & 3) * NUP + (a >> 2) * DFF)) + ff;
            __builtin_amdgcn_global_load_lds((const unsigned*)sp, (LAS unsigned*)(tb + i * 64), 4, 0, 0); }
#pragma unroll
        for (int i = 0; i < 2; ++i) __builtin_amdgcn_global_load_lds((const unsigned*)(rs + u.pm * BM + i * HALF + wr * 64 + L), (LAS unsigned*)(tb + 256 + i * 64), 4, 0, 0);
    }
    __device__ __forceinline__ void operator()(f32x4 (&acc)[2][2][4][2], const Unit& u, int wr, int wc, int fr, int fq, int par) const {
        asm volatile("" : "+v"(fr), "+v"(fq));
        typedef float f32x2 __attribute__((ext_vector_type(2)));
        const int f0 = u.pn * 128 + wc * 32 + 8 * fq;
        const int Rb = u.pm * BM + wr * 64 + fr;
        LAS float* tb = (LAS float*)(xl + LDS_XTRA + (par * 8 + wr * 4 + wc) * 1536);
#pragma unroll
        for (int ai = 0; ai < 2; ++ai)
#pragma unroll
            for (int m = 0; m < 4; ++m) { const float sc = tb[256 + ai * 64 + m * 16 + fr];
#pragma unroll
                for (int bj = 0; bj < 2; ++bj)
#pragma unroll
                    for (int n = 0; n < 2; ++n) acc[ai][bj][m][n] *= sc; }
        f32x2 W[2][8];
#define EPIUP_LOADW(slot, it) do { const int fo_ = 8 * fq + 4 * ((it) >> 1) + 2 * ((it) & 1); _Pragma("unroll") for (int a_ = 0; a_ < 8; ++a_) W[slot][a_] = *(const LAS f32x2*)(tb + a_ * 32 + fo_); } while (0)
        EPIUP_LOADW(0, 0);
        unsigned pk[2][4][4];
#pragma unroll
        for (int it = 0; it < 4; ++it) {
            __builtin_amdgcn_sched_barrier(0);
            const int n = it >> 1, jp = it & 1, sl = it & 1;
            if (it < 3) EPIUP_LOADW(sl ^ 1, it + 1);
#pragma unroll
            for (int ai = 0; ai < 2; ++ai) {
#pragma unroll
                for (int m = 0; m < 4; ++m) {
                    f32x2 xg, xv, g1, g2, v1, v2;
#pragma unroll
                    for (int jj = 0; jj < 2; ++jj) {
                        const int j = 2 * jp + jj;
                        xg[jj] = acc[ai][0][m][n][j]; xv[jj] = acc[ai][1][m][n][j];
                        const float pg = m ? acc[ai][0][m ? m - 1 : 0][n][j] : 0.f, pv = m ? acc[ai][1][m ? m - 1 : 0][n][j] : 0.f;
                        g1[jj] = row_shift<1>(pg, xg[jj]); g2[jj] = row_shift<2>(pg, xg[jj]); v1[jj] = row_shift<1>(pv, xv[jj]); v2[jj] = row_shift<2>(pv, xv[jj]);
                    }
                    const f32x2 cg_ = W[sl][0] * g2 + W[sl][1] * g1 + W[sl][2] * xg + W[sl][3];
                    const f32x2 cv_ = W[sl][4] * v2 + W[sl][5] * v1 + W[sl][6] * xv + W[sl][7];
                    pk[ai][m][it] = cvt_pk_bf16(silu_f(cg_[0]) * cv_[0], silu_f(cg_[1]) * cv_[1]);
                }
            }
        }
        __builtin_amdgcn_sched_barrier(0);
#pragma unroll
        for (int ai = 0; ai < 2; ++ai)
#pragma unroll
            for (int m = 0; m < 4; ++m) { u32x4 w; w.x = pk[ai][m][0]; w.y = pk[ai][m][1]; w.z = pk[ai][m][2]; w.w = pk[ai][m][3];
                *(u32x4*)((char*)ACT + ((unsigned)(Rb + ai * HALF + m * 16) * (unsigned)DFF + (unsigned)f0) * 2u) = w; }
#undef EPIUP_LOADW
        __builtin_amdgcn_sched_barrier(0);
#pragma unroll
        for (int ai = 0; ai < 2; ++ai)
#pragma unroll
            for (int m = 0; m < 4; ++m) {
                const bool lo = ((m & 1) == 0) && fr < 2, hi = ((m & 1) == 1) && fr >= 14;
                if ((lo || hi) && (m == 0 || m == 3 || u.pm >= MP / BM)) {
                    const int R = Rb + ai * HALF + m * 16;
                    const int slot = lo ? 2 + fr : fr - 14;
                    bf16_t* rb = RAW + ((size_t)(R >> 5) * 4 + slot) * NUP + f0;
                    float* dst = nullptr;
                    if (hi) { if (R < MP) { if ((R & 2047) >= 2046) dst = outp + ((size_t)(R >> 11) * 2 + ((R & 2047) - 2046)) * NUP + f0; }
                              else dst = outs + ((size_t)((R - MP) >> 5) * 2 + ((R & 31) - 30)) * NUP + f0; }
#pragma unroll
                    for (int n = 0; n < 2; ++n) {
                        const f32x4 xg = acc[ai][0][m][n], xv = acc[ai][1][m][n];
                        u32x2 w; w.x = cvt_pk_bf16(xg[0], xg[1]); w.y = cvt_pk_bf16(xg[2], xg[3]); *(u32x2*)(rb + 4 * n) = w;
                        w.x = cvt_pk_bf16(xv[0], xv[1]); w.y = cvt_pk_bf16(xv[2], xv[3]); *(u32x2*)(rb + DFF + 4 * n) = w;
                        if (dst) { *(f32x4*)(dst + 4 * n) = xg; *(f32x4*)(dst + DFF + 4 * n) = xv; }
                    }
                }
            }
    }
};

template <class Epi, class Sched>
__device__ __forceinline__ void gemm_phase(LAS unsigned char* lds, const Gemm g, const Sched& S, const Epi& E, const int tid) {
    const int wid = __builtin_amdgcn_readfirstlane(tid >> 6), lane = tid & 63, wr = wid >> 2, wc = wid & 3, fr = lane & 15, fq = lane >> 4;
    const int K = g.K, nt = K / BK;
    unsigned voffA[2], voffB[2];
#pragma unroll
    for (int i = 0; i < 2; ++i) { int R, C; stage_rc(tid * 16 + i * 8192, R, C); const int Rb = (R >> 5) * 64 + (Epi::PERM ? perm32(R & 31) : (R & 31));
        voffA[i] = (unsigned)(R * K + C) * 2u; voffB[i] = (unsigned)(Rb * K + C) * 2u; }
    const size_t kstep = (size_t)(BK * 2);
    const size_t hstep = (size_t)HALF * K * 2;
    const size_t tstep = 2 * hstep;
    const size_t hstepB = (size_t)32 * K * 2;
    const unsigned ldsw = (unsigned)wid * 1024u;
    const int aoff = lds_byte(wr * 64 + fr, fq * 8), boff = lds_byte(wc * 32 + fr, fq * 8);
#define PG8_SA(b, h) (((b) * 2 + (h)) * HTB)
#define PG8_SB(b, h) ((4 + (b) * 2 + (h)) * HTB)
#define PG8_STAGE(bufoff, gbase, voff) do { _Pragma("unroll") for (int _i = 0; _i < 2; ++_i) \
        __builtin_amdgcn_global_load_lds((const unsigned*)((const char*)(gbase) + (voff)[_i]), (LAS unsigned*)(lds + (bufoff) + ldsw + _i * 8192), 16, 0, 0); } while (0)
#define PG8_LDA(dst, b, h) do { _Pragma("unroll") for (int m = 0; m < 4; ++m) _Pragma("unroll") for (int k = 0; k < 2; ++k) dst[m][k] = *(const LAS bf16x8*)(lds + PG8_SA(b, h) + aoff + m * 2048 + k * 1024); } while (0)
#define PG8_LDB(dst, b, h) do { _Pragma("unroll") for (int n = 0; n < 2; ++n) _Pragma("unroll") for (int k = 0; k < 2; ++k) dst[n][k] = *(const LAS bf16x8*)(lds + PG8_SB(b, h) + boff + n * 2048 + k * 1024); } while (0)
#define PG8_MMA(ai, bj, At, Bt) do { __builtin_amdgcn_s_setprio(1); _Pragma("unroll") for (int m = 0; m < 4; ++m) _Pragma("unroll") for (int n = 0; n < 2; ++n) _Pragma("unroll") for (int k = 0; k < 2; ++k) \
        acc[ai][bj][m][n] = __builtin_amdgcn_mfma_f32_16x16x32_bf16(Bt[n][k], At[m][k], acc[ai][bj][m][n], 0, 0, 0); __builtin_amdgcn_s_setprio(0); } while (0)
#define PG8_WAIT_V(n) asm volatile("s_waitcnt vmcnt(" #n ")" ::: "memory")
#define PG8_WAIT_L(n) asm volatile("s_waitcnt lgkmcnt(" #n ")" ::: "memory")
#define PG8_BAR __builtin_amdgcn_s_barrier()
#define PG8_SCHED __builtin_amdgcn_sched_barrier(0)
    Unit cur, nxt; int ui = 0;
    if (!S.next(0, cur)) return;
    f32x4 acc[2][2][4][2];
#pragma unroll
    for (int a = 0; a < 2; ++a)
#pragma unroll
        for (int b = 0; b < 2; ++b)
#pragma unroll
            for (int m = 0; m < 4; ++m)
#pragma unroll
                for (int n = 0; n < 2; ++n) acc[a][b][m][n] = (f32x4){0.f, 0.f, 0.f, 0.f};
    bf16x8 At[4][2], B0[2][2], B1[2][2];
    const char* cA = (const char*)g.A + (size_t)cur.pm * tstep; const char* cB = (const char*)g.Bt + (size_t)cur.pn * tstep;
    S.a_ready(cur); E.prefetch(cur, 0, wr, wc, lane);
    PG8_STAGE(PG8_SB(0, 0), cB, voffB); PG8_STAGE(PG8_SA(0, 0), cA, voffA); PG8_STAGE(PG8_SB(0, 1), cB + hstepB, voffB); PG8_STAGE(PG8_SA(0, 1), cA + hstep, voffA);
    if (wr == 1) PG8_BAR;
    PG8_WAIT_V(4); PG8_BAR;
    PG8_STAGE(PG8_SB(1, 0), cB + kstep, voffB); PG8_STAGE(PG8_SA(1, 0), cA + kstep, voffA); PG8_STAGE(PG8_SB(1, 1), cB + hstepB + kstep, voffB);
    PG8_WAIT_V(6); PG8_BAR;
    for (;;) {
        const bool has_next = S.next(ui + 1, nxt);
        const char* nA = has_next ? (const char*)g.A + (size_t)nxt.pm * tstep : cA; const char* nB = has_next ? (const char*)g.Bt + (size_t)nxt.pn * tstep : cB;
        for (int t = 0; t < nt; t += 2) {
            const bool last = (t == nt - 2);
            const char* a1 = cA + (size_t)(t + 1) * kstep;
            const char* a2 = last ? nA : cA + (size_t)(t + 2) * kstep; const char* b2 = last ? nB : cB + (size_t)(t + 2) * kstep;
            const char* a3 = a2 + kstep; const char* b3 = b2 + kstep;
            if (last && has_next) { S.a_ready(nxt); E.prefetch(nxt, (ui + 1) & 1, wr, wc, lane); }
            PG8_LDB(B0, 0, 0); PG8_SCHED; PG8_LDA(At, 0, 0); PG8_STAGE(PG8_SA(1, 1), a1 + hstep, voffA);
            PG8_WAIT_L(8); PG8_BAR; PG8_WAIT_L(0); PG8_MMA(0, 0, At, B0); PG8_BAR; PG8_SCHED;
            PG8_LDB(B1, 0, 1); PG8_STAGE(PG8_SB(0, 0), b2, voffB);
            PG8_BAR; PG8_WAIT_L(0); PG8_MMA(0, 1, At, B1); PG8_BAR;
            PG8_LDA(At, 0, 1); PG8_STAGE(PG8_SA(0, 0), a2, voffA);
            PG8_BAR; PG8_WAIT_L(0); PG8_MMA(1, 0, At, B0); PG8_BAR; PG8_SCHED;
            PG8_STAGE(PG8_SB(0, 1), b2 + hstepB, voffB);
            PG8_WAIT_V(6); PG8_BAR; PG8_MMA(1, 1, At, B1); PG8_BAR;
            PG8_LDB(B0, 1, 0); PG8_SCHED; PG8_LDA(At, 1, 0); PG8_STAGE(PG8_SA(0, 1), a2 + hstep, voffA);
            PG8_WAIT_L(8); PG8_BAR; PG8_WAIT_L(0); PG8_MMA(0, 0, At, B0); PG8_BAR; PG8_SCHED;
            PG8_LDB(B1, 1, 1); PG8_STAGE(PG8_SB(1, 0), b3, voffB);
            PG8_BAR; PG8_WAIT_L(0); PG8_MMA(0, 1, At, B1); PG8_BAR;
            PG8_LDA(At, 1, 1); PG8_STAGE(PG8_SA(1, 0), a3, voffA);
            PG8_BAR; PG8_WAIT_L(0); PG8_MMA(1, 0, At, B0); PG8_BAR; PG8_SCHED;
            PG8_STAGE(PG8_SB(1, 1), b3 + hstepB, voffB);
            PG8_WAIT_V(6); PG8_BAR; PG8_MMA(1, 1, At, B1); PG8_BAR;
        }
        E(acc, cur, wr, wc, fr, fq, ui & 1); S.done(cur);
        if (!has_next) break;
#pragma unroll
        for (int a = 0; a < 2; ++a)
#pragma unroll
            for (int b = 0; b < 2; ++b)
#pragma unroll
                for (int m = 0; m < 4; ++m)
#pragma unroll
                    for (int n = 0; n < 2; ++n) acc[a][b][m][n] = (f32x4){0.f, 0.f, 0.f, 0.f};
        cur = nxt; cA = nA; cB = nB; ++ui;
    }
    PG8_WAIT_V(0);
    if (wr == 0) PG8_BAR;
    PG8_BAR;
#undef PG8_SA
#undef PG8_SB
#undef PG8_STAGE
#undef PG8_LDA
#undef PG8_LDB
#undef PG8_MMA
#undef PG8_WAIT_V
#undef PG8_WAIT_L
#undef PG8_BAR
#undef PG8_SCHED
}
}


__device__ __forceinline__ void small_gemm(LAS unsigned char* lds, const bf16_t* A, const bf16_t* Bt, int N, int K, bf16_t* O, int ldc, const float* rs, int bid, int G, int tid, int wid, int lane) {
    const int fr = lane & 15, fq = lane >> 4, kq = wid >> 1, rh = wid & 1;
    const int nct = N >> 6, nunits = 16 * nct, kslice = K >> 2, nks = kslice >> 5;
    LAS float* P = (LAS float*)lds;
    for (int u = bid; u < nunits; u += G) {
        const int rt = u / nct, ct = u - rt * nct;
        const bf16_t* ap = A + (size_t)(MP + rt * 64 + rh * 32 + fr) * K + kq * kslice + fq * 8;
        const bf16_t* bp = Bt + (size_t)(ct * 64 + fr) * K + kq * kslice + fq * 8;
        f32x4 acc[2][4];
#pragma unroll
        for (int rb = 0; rb < 2; ++rb)
#pragma unroll
            for (int cb = 0; cb < 4; ++cb) acc[rb][cb] = (f32x4){0.f, 0.f, 0.f, 0.f};
        for (int c0 = 0; c0 < nks; c0 += 4) {
            bf16x8 a[4][2], b[4][4];
#pragma unroll
            for (int i = 0; i < 4; ++i) { const int ks = (c0 + i < nks) ? c0 + i : nks - 1;
#pragma unroll
                for (int rb = 0; rb < 2; ++rb) a[i][rb] = *(const bf16x8*)(ap + (size_t)rb * 16 * K + ks * 32);
#pragma unroll
                for (int cb = 0; cb < 4; ++cb) b[i][cb] = *(const bf16x8*)(bp + (size_t)cb * 16 * K + ks * 32); }
            __builtin_amdgcn_sched_barrier(0);
#pragma unroll
            for (int i = 0; i < 4; ++i) { if (c0 + i < nks) {
#pragma unroll
                for (int rb = 0; rb < 2; ++rb)
#pragma unroll
                    for (int cb = 0; cb < 4; ++cb) acc[rb][cb] = __builtin_amdgcn_mfma_f32_16x16x32_bf16(b[i][cb], a[i][rb], acc[rb][cb], 0, 0, 0); } }
            __builtin_amdgcn_sched_barrier(0);
        }
#pragma unroll
        for (int rb = 0; rb < 2; ++rb)
#pragma unroll
            for (int cb = 0; cb < 4; ++cb) *(LAS f32x4*)(P + (kq * 64 + rh * 32 + rb * 16 + fr) * 68 + cb * 16 + fq * 4) = acc[rb][cb];
        __syncthreads();
        { const int row = tid >> 3, c8 = (tid & 7) * 8; float f[8];
          f32x4 s0 = *(const LAS f32x4*)(P + row * 68 + c8), s1 = *(const LAS f32x4*)(P + row * 68 + c8 + 4);
#pragma unroll
          for (int q = 1; q < 4; ++q) { s0 += *(const LAS f32x4*)(P + (q * 64 + row) * 68 + c8); s1 += *(const LAS f32x4*)(P + (q * 64 + row) * 68 + c8 + 4); }
          const float sc = rs ? rs[MP + rt * 64 + row] : 1.0f; s0 *= sc; s1 *= sc;
          f[0] = s0[0]; f[1] = s0[1]; f[2] = s0[2]; f[3] = s0[3]; f[4] = s1[0]; f[5] = s1[1]; f[6] = s1[2]; f[7] = s1[3];
          *(u32x4*)(O + (size_t)(MP + rt * 64 + row) * ldc + ct * 64 + c8) = pack8(f); }
        __syncthreads();
    }
}

__device__ __forceinline__ void convert_cache(const float* ck, const float* cv, bf16_t* KC, bf16_t* VCT, LAS unsigned char* lds, int bid, int G, int tid, int gtid, int nthr) {
    for (int i = gtid; i < 32 * 256 * 1024 / 8; i += nthr) {
        const f32x4 a = __builtin_nontemporal_load((const f32x4*)(ck + (size_t)i * 8)), b = __builtin_nontemporal_load((const f32x4*)(ck + (size_t)i * 8 + 4));
        u32x4 w; w.x = cvt_pk_bf16(a[0], a[1]); w.y = cvt_pk_bf16(a[2], a[3]); w.z = cvt_pk_bf16(b[0], b[1]); w.w = cvt_pk_bf16(b[2], b[3]);
        *(u32x4*)(KC + (size_t)i * 8) = w;
    }
    { LAS float* T = (LAS float*)lds;
      for (int tile = bid; tile < 32 * 4 * 16; tile += G) {
        const int s = tile >> 6, h = (tile >> 4) & 3, r0 = ((tile >> 2) & 3) * 64, e0 = (tile & 3) * 64;
        { const int rr = tid >> 3, ec = (tid & 7) * 8; const float* sp = cv + ((size_t)(s * 256 + r0 + rr) * 4 + h) * 256 + e0 + ec;
          const f32x4 a = __builtin_nontemporal_load((const f32x4*)sp), b = __builtin_nontemporal_load((const f32x4*)(sp + 4));
          LAS float* tp = T + rr * 65 + ec; tp[0] = a[0]; tp[1] = a[1]; tp[2] = a[2]; tp[3] = a[3]; tp[4] = b[0]; tp[5] = b[1]; tp[6] = b[2]; tp[7] = b[3]; }
        __syncthreads();
        { const int ee = tid >> 3, rc = (tid & 7) * 8; float f[8];
#pragma unroll
          for (int i = 0; i < 8; ++i) f[i] = T[(rc + i) * 65 + ee];
          *(u32x4*)(VCT + ((size_t)(s * 4 + h) * 256 + e0 + ee) * 256 + r0 + rc) = pack8(f); }
        __syncthreads();
      } }
}

__device__ __forceinline__ void weight_tile(PP pp, bf16_t* W, bf16_t* WKV, LAS float* T, int l, int tl, int tid) {
        const float* src; bf16_t* dst; const float* gfold = nullptr; int K, N, t, upmap = 0;
        if (tl < 512) { src = pp->in[I_WIN] + (size_t)l * 1024 * 2048; K = 1024; N = 2048; dst = W + l * WL_ELEMS + WL_WIN; t = tl; gfold = pp->in[I_GMIXPRE] + l * 1024; }
        else if (tl < 768) { src = pp->in[I_WOUT] + (size_t)l * 1048576; K = 1024; N = 1024; dst = W + l * WL_ELEMS + WL_WOUT; t = tl - 512; }
        else if (tl < 1024) { src = pp->in[I_WQ] + (size_t)l * 1048576; K = 1024; N = 1024; dst = W + l * WL_ELEMS + WL_WQ; t = tl - 768; gfold = pp->in[I_GATTPRE] + l * 1024; }
        else if (tl < 1280) { src = pp->in[I_WO] + (size_t)l * 1048576; K = 1024; N = 1024; dst = W + l * WL_ELEMS + WL_WO; t = tl - 1024; }
        else if (tl < 2688) { src = pp->in[I_WUP] + (size_t)l * 1024 * NUP; K = 1024; N = NUP; dst = W + l * WL_ELEMS + WL_WUP; t = tl - 1280; upmap = 1; gfold = pp->in[I_GFFNPRE] + l * 1024; }
        else if (tl < 3392) { src = pp->in[I_WDOWN] + (size_t)l * DFF * 1024; K = DFF; N = 1024; dst = W + l * WL_ELEMS + WL_WDOWN; t = tl - 2688; }
        else if (tl < 3648) { src = pp->in[I_WK] + (size_t)l * 1048576; K = 1024; N = 1024; dst = WKV + (size_t)(l * 2048) * 1024; t = tl - 3392; }
        else { src = pp->in[I_WV] + (size_t)l * 1048576; K = 1024; N = 1024; dst = WKV + (size_t)(l * 2048 + 1024) * 1024; t = tl - 3648; }
        const int ntn = N >> 6, tk = t / ntn, tn = t % ntn, k0 = tk * 64, n0 = tn * 64;
        { const int kr = tid >> 3, nc = (tid & 7) * 8; const float* sp = src + (size_t)(k0 + kr) * N + n0 + nc;
          const float gk = gfold ? gfold[k0 + kr] : 1.0f;
          const f32x4 a = __builtin_nontemporal_load((const f32x4*)sp) * gk, b = __builtin_nontemporal_load((const f32x4*)(sp + 4)) * gk;
          LAS float* tp = T + kr * 65 + nc; tp[0] = a[0]; tp[1] = a[1]; tp[2] = a[2]; tp[3] = a[3]; tp[4] = b[0]; tp[5] = b[1]; tp[6] = b[2]; tp[7] = b[3]; }
        __syncthreads();
        { const int nr = tid >> 3, kc = (tid & 7) * 8; float f[8];
#pragma unroll
          for (int i = 0; i < 8; ++i) f[i] = T[(kc + i) * 65 + nr];
          int n = n0 + nr;
          if (upmap) { const int bj = n >= DFF ? 1 : 0, ff = n - bj * DFF; n = ((ff >> 7) << 8) + (((ff & 127) >> 5) << 6) + (bj << 5) + (ff & 31); }
          *(u32x4*)(dst + (size_t)n * K + k0 + kc) = pack8(f); }
        __syncthreads();
}
__device__ __forceinline__ void pool_weight_chunk(PP pp, bf16_t* W, int l, int i) {
    const int n = (i >> 6) & 511, kc = (i & 63) * 8, g = n >> 7; float f[8];
    const float sc = pp->in[I_PSCALE][l * 512 + n];
#pragma unroll
    for (int k = 0; k < 8; ++k) { const int kk = kc + k; f[k] = ((kk >> 7) == g) ? pp->in[I_WPOOL][(((size_t)l * 4 + g) * 128 + (kk & 127)) * 128 + (n & 127)] * sc : 0.f; }
    *(u32x4*)(W + l * WL_ELEMS + WL_POOL + (size_t)n * 512 + kc) = pack8(f);
}
__device__ __forceinline__ void deferred_weights(PP pp, LAS unsigned char* lds, int l, int tl0, int tl1, bool pool, int rank, int nrank, int tid) {
    bf16_t* W = (bf16_t*)(pp->ws + WS_W); bf16_t* WKV = (bf16_t*)(pp->ws + WS_WKV);
    LAS float* T = (LAS float*)lds;
    for (int tl = tl0 + rank; tl < tl1; tl += nrank) weight_tile(pp, W, WKV, T, l, tl, tid);
    if (pool) for (int i = rank * 512 + tid; i < 512 * 64; i += nrank * 512) pool_weight_chunk(pp, W, l, i);
}
__device__ __forceinline__ void prep_phase(PP pp, LAS unsigned char* lds, int bid, int G, int tid, int wid, int lane) {
    bf16_t* W = (bf16_t*)(pp->ws + WS_W); bf16_t* WKV = (bf16_t*)(pp->ws + WS_WKV);
    LAS float* T = (LAS float*)lds;
    for (int t2 = bid; t2 < 512 + 512 + 512; t2 += G) { if (t2 < 512) weight_tile(pp, W, WKV, T, 0, t2, tid); else if (t2 < 1024) weight_tile(pp, W, WKV, T, 0, 3392 + (t2 - 512), tid); else weight_tile(pp, W, WKV, T, 1, 3392 + (t2 - 1024), tid); }
    const int gtid = bid * 512 + tid, nthr = G * 512, gwave = bid * 8 + wid, nwaves = G * 8;
    for (int i = gtid; i < 512 * 64; i += nthr) pool_weight_chunk(pp, W, 0, i);
    { bf16_t* XB = (bf16_t*)(pp->ws + WS_H); float* RS = (float*)(pp->ws + WS_RS);
      for (int r = gwave; r < MT; r += nwaves) {
        const float* xr = r < MP ? pp->in[I_XP] + (size_t)r * 1024 : pp->in[I_XS] + (size_t)(r - MP) * 1024;
        f32x4 x[4]; float ss = 0.f;
#pragma unroll
        for (int i = 0; i < 4; ++i) { x[i] = __builtin_nontemporal_load((const f32x4*)(xr + i * 256 + lane * 4)); ss += x[i][0] * x[i][0] + x[i][1] * x[i][1] + x[i][2] * x[i][2] + x[i][3] * x[i][3]; }
        ss = wave_sum(ss, lane);
        if (lane == 0) RS[r] = rsqrtf(ss * (1.0f / 1024.0f) + 1e-6f);
#pragma unroll
        for (int i = 0; i < 4; ++i) { u32x2 w; w.x = cvt_pk_bf16(x[i][0], x[i][1]); w.y = cvt_pk_bf16(x[i][2], x[i][3]);
            *(u32x2*)(XB + (size_t)r * 1024 + i * 256 + lane * 4) = w; }
      } }
    { bf16_t* MEMN = (bf16_t*)(pp->ws + WS_MEMN);
      for (int r = gwave; r < 4096; r += nwaves) {
        const float* xr = pp->in[I_MEM] + (size_t)r * 1024; f32x4 x[4]; float ss = 0.f;
#pragma unroll
        for (int i = 0; i < 4; ++i) { x[i] = __builtin_nontemporal_load((const f32x4*)(xr + i * 256 + lane * 4)); ss += x[i][0] * x[i][0] + x[i][1] * x[i][1] + x[i][2] * x[i][2] + x[i][3] * x[i][3]; }
        ss = wave_sum(ss, lane); const float rs = rsqrtf(ss * (1.0f / 1024.0f) + 1e-6f);
#pragma unroll
        for (int l = 0; l < 2; ++l)
#pragma unroll
            for (int i = 0; i < 4; ++i) { const f32x4 g = *(const f32x4*)(pp->in[I_GMEM] + l * 1024 + i * 256 + lane * 4);
                u32x2 w; w.x = cvt_pk_bf16(x[i][0] * rs * g[0], x[i][1] * rs * g[1]); w.y = cvt_pk_bf16(x[i][2] * rs * g[2], x[i][3] * rs * g[3]);
                *(u32x2*)(MEMN + ((size_t)l * 4096 + r) * 1024 + i * 256 + lane * 4) = w; }
      } }
    convert_cache(pp->in[I_CK], pp->in[I_CV], (bf16_t*)(pp->ws + WS_KC), (bf16_t*)(pp->ws + WS_VCT), lds, bid, G, tid, gtid, nthr);
}

template <bool FAST> __device__ __forceinline__ void mix_load_u(const bf16_t* PROJ, const float* hist15, bool prompt, int Rr, int tt, int f0, float* u) {
    if (FAST || tt >= 0) unpack8(*(const u32x4*)(PROJ + (size_t)Rr * 2048 + f0), u);
    else if (!prompt) { const float* hp = hist15 + (size_t)(15 + tt) * 512 + f0; const f32x4 a = *(const f32x4*)hp, b = *(const f32x4*)(hp + 4);
        u[0] = a[0]; u[1] = a[1]; u[2] = a[2]; u[3] = a[3]; u[4] = b[0]; u[5] = b[1]; u[6] = b[2]; u[7] = b[3]; }
    else {
#pragma unroll
        for (int q = 0; q < 8; ++q) u[q] = 0.f; }
}
template <bool FAST> __device__ __forceinline__ void mixer_run(const bf16_t* PROJ, LAS unsigned char* DL, bf16_t* YCAT, const float* hist15, const float* hist2, float* pool_out, float* conv_out,
                                                                const float (&cw0)[8], const float (&cw1)[8], const float (&cw2)[8], const float (&cbv)[8],
                                                                bool prompt, int R0, int t0, int nrows, int T, int lane) {
    const int f0 = lane * 8, w = 2 << (lane >> 4);
    float S[8];
#pragma unroll
    for (int q = 0; q < 8; ++q) S[q] = 0.f;
    for (int k = 1; k < 16; ++k) {
        if (k < w) { float u[8]; mix_load_u<FAST>(PROJ, hist15, prompt, R0 - k, t0 - k, f0, u);
#pragma unroll
            for (int q = 0; q < 8; ++q) S[q] += u[q]; }
    }
    float cv1[8], cv2[8];
#pragma unroll
    for (int hh = 1; hh <= 2; ++hh) {
        const int tt = t0 - hh; float x[8];
        if (FAST || tt >= 0) { float c[8], v[8]; const bf16_t* pr = PROJ + (size_t)(R0 - hh) * 2048 + f0; unpack8(*(const u32x4*)(pr + 1024), c); unpack8(*(const u32x4*)(pr + 1536), v);
#pragma unroll
            for (int q = 0; q < 8; ++q) x[q] = c[q] * v[q]; }
        else if (!prompt) { const float* hp = hist2 + (size_t)(2 + tt) * 512 + f0;
#pragma unroll
            for (int q = 0; q < 8; ++q) x[q] = hp[q]; }
        else {
#pragma unroll
            for (int q = 0; q < 8; ++q) x[q] = 0.f; }
#pragma unroll
        for (int q = 0; q < 8; ++q) { if (hh == 1) cv1[q] = x[q]; else cv2[q] = x[q]; }
    }
    for (int i0 = 0; i0 < nrows; i0 += 4) {
        float un[4][8], uo[4][8]; u32x4 lb[4], lc[4], lv[4];
#pragma unroll
        for (int r = 0; r < 4; ++r) {
            const int R = R0 + i0 + r, t = t0 + i0 + r; const bf16_t* pr = PROJ + (size_t)R * 2048 + f0;
            unpack8(*(const u32x4*)pr, un[r]);
            mix_load_u<FAST>(PROJ, hist15, prompt, R - w + 1, t - w + 1, f0, uo[r]);
            lb[r] = *(const u32x4*)(pr + 512); lc[r] = *(const u32x4*)(pr + 1024); lv[r] = *(const u32x4*)(pr + 1536);
        }
#pragma unroll
        for (int r = 0; r < 4; ++r) {
            const int R = R0 + i0 + r, t = t0 + i0 + r;
            const int cnt = (FAST || !prompt) ? w : (w < t + 1 ? w : t + 1); const float ic = 1.0f / (float)cnt;
            float d[8];
#pragma unroll
            for (int q = 0; q < 8; ++q) { S[q] += un[r][q]; d[q] = S[q] * ic - un[r][q]; S[q] -= uo[r][q]; }
            *(LAS u32x4*)(DL + (i0 + r) * DT_PITCH + f0 * 2) = pack8(d);
            if (t >= T - 15) { float* pn = pool_out + (size_t)(t - (T - 15)) * 512 + f0;
                *(f32x4*)pn = (f32x4){un[r][0], un[r][1], un[r][2], un[r][3]}; *(f32x4*)(pn + 4) = (f32x4){un[r][4], un[r][5], un[r][6], un[r][7]}; }
            float b[8], c[8], v[8], cv0[8], yb[8];
            unpack8(lb[r], b); unpack8(lc[r], c); unpack8(lv[r], v);
#pragma unroll
            for (int q = 0; q < 8; ++q) { cv0[q] = c[q] * v[q]; yb[q] = b[q] * (cw0[q] * cv2[q] + cw1[q] * cv1[q] + cw2[q] * cv0[q] + cbv[q]); }
            *(u32x4*)(YCAT + (size_t)R * 1024 + 512 + f0) = pack8(yb);
            if (t >= T - 2) { float* cn = conv_out + (size_t)(t - (T - 2)) * 512 + f0;
                *(f32x4*)cn = (f32x4){cv0[0], cv0[1], cv0[2], cv0[3]}; *(f32x4*)(cn + 4) = (f32x4){cv0[4], cv0[5], cv0[6], cv0[7]}; }
#pragma unroll
            for (int q = 0; q < 8; ++q) { cv2[q] = cv1[q]; cv1[q] = cv0[q]; }
        }
    }
}
__device__ __forceinline__ void transpose_vrow(const bf16_t* VROW, bf16_t* VPT, LAS unsigned char* lds, int bid, int G, int tid) {
    LAS float* T = (LAS float*)lds;
    for (int tile = bid; tile < 32 * 4 * 16; tile += G) {
        const int ls = tile >> 6, h = (tile >> 4) & 3, r0 = ((tile >> 2) & 3) * 64, e0 = (tile & 3) * 64;
        { const int rr = tid >> 3, ec = (tid & 7) * 8; float f[8]; unpack8(*(const u32x4*)(VROW + (size_t)(ls * 256 + r0 + rr) * 1024 + h * 256 + e0 + ec), f);
          LAS float* tp = T + rr * 65 + ec;
#pragma unroll
          for (int i = 0; i < 8; ++i) tp[i] = f[i]; }
        __syncthreads();
        { const int ee = tid >> 3, rc = (tid & 7) * 8; float f[8];
#pragma unroll
          for (int i = 0; i < 8; ++i) f[i] = T[(rc + i) * 65 + ee];
          *(u32x4*)(VPT + ((size_t)(ls * 4 + h) * 256 + e0 + ee) * 256 + r0 + rc) = pack8(f); }
        __syncthreads();
    }
}
__device__ __forceinline__ void mixer_phase(PP pp, LAS unsigned char* lds, int l, int bid, int G, int wid, int lane) {
    const bf16_t* PROJ = (const bf16_t*)(pp->ws + BIG_PROJ); bf16_t* YCAT = (bf16_t*)(pp->ws + BIG_YCAT);
    const float* spool = pp->in[I_SPOOL] + (size_t)l * 32 * 15 * 512; const float* sconv = pp->in[I_SCONV] + (size_t)l * 32 * 2 * 512;
    float* opp = pp->out + O_POOLP + (size_t)l * 16 * 15 * 512; float* ops = pp->out + O_POOLS + (size_t)l * 32 * 15 * 512;
    float* ocp = pp->out + O_CONVP + (size_t)l * 16 * 2 * 512; float* ocs = pp->out + O_CONVS + (size_t)l * 32 * 2 * 512;
    const int f0 = lane * 8, fr = lane & 15, fq = lane >> 4;
    float cw0[8], cw1[8], cw2[8], cbv[8];
    { const float* cwp = pp->in[I_CONVW] + (size_t)l * 3 * 512; const float* cbp = pp->in[I_CONVB] + (size_t)l * 512;
#pragma unroll
      for (int k = 0; k < 8; ++k) { cw0[k] = cwp[f0 + k]; cw1[k] = cwp[512 + f0 + k]; cw2[k] = cwp[1024 + f0 + k]; cbv[k] = cbp[f0 + k]; } }
    const bf16_t* PT = (const bf16_t*)(pp->ws + WS_W) + (size_t)l * WL_ELEMS + WL_POOL;
    if (l == 0) transpose_vrow((const bf16_t*)(pp->ws + WS_VROW), (bf16_t*)(pp->ws + WS_VPT), lds, bid, G, wid * 64 + lane);
    const int g = wid >> 1, nh = wid & 1;
    for (int task = bid; task < 256 + 32; task += G) {
        const bool prompt = task < 256; const int rpw = prompt ? 16 : 4;
        const int R0 = prompt ? task * 128 : MP + (task - 256) * 32;
        const int Rw = R0 + wid * rpw;
        LAS unsigned char* DL = lds + wid * rpw * DT_PITCH;
        if (prompt) { const int s = Rw >> 11, t0 = Rw & 2047;
            if (t0 >= 16) mixer_run<true>(PROJ, DL, YCAT, spool, sconv, opp + (size_t)s * 15 * 512, ocp + (size_t)s * 2 * 512, cw0, cw1, cw2, cbv, true, Rw, t0, 16, 2048, lane);
            else mixer_run<false>(PROJ, DL, YCAT, spool, sconv, opp + (size_t)s * 15 * 512, ocp + (size_t)s * 2 * 512, cw0, cw1, cw2, cbv, true, Rw, t0, 16, 2048, lane);
        } else { const int s = (Rw - MP) >> 5, t0 = Rw & 31;
            mixer_run<false>(PROJ, DL, YCAT, spool + (size_t)s * 15 * 512, sconv + (size_t)s * 2 * 512, ops + (size_t)s * 15 * 512, ocs + (size_t)s * 2 * 512, cw0, cw1, cw2, cbv, false, Rw, t0, 4, 32, lane); }
        bf16x8 A[4][4];
#pragma unroll
        for (int nb = 0; nb < 4; ++nb)
#pragma unroll
            for (int ks = 0; ks < 4; ++ks) A[nb][ks] = *(const bf16x8*)(PT + (size_t)(g * 128 + nh * 64 + nb * 16 + fr) * 512 + g * 128 + ks * 32 + fq * 8);
        __syncthreads();
        const int nrb = prompt ? 8 : 2;
        for (int rb = 0; rb < nrb; ++rb) {
            bf16x8 B[4];
#pragma unroll
            for (int ks = 0; ks < 4; ++ks) B[ks] = *(const LAS bf16x8*)(lds + (rb * 16 + fr) * DT_PITCH + (g * 128 + ks * 32 + fq * 8) * 2);
#pragma unroll
            for (int nb = 0; nb < 4; ++nb) {
                f32x4 a = (f32x4){0.f, 0.f, 0.f, 0.f};
#pragma unroll
                for (int ks = 0; ks < 4; ++ks) a = __builtin_amdgcn_mfma_f32_16x16x32_bf16(A[nb][ks], B[ks], a, 0, 0, 0);
                u32x2 w; w.x = cvt_pk_bf16(a[0], a[1]); w.y = cvt_pk_bf16(a[2], a[3]);
                *(u32x2*)(YCAT + (size_t)(R0 + rb * 16 + fr) * 1024 + g * 128 + nh * 64 + nb * 16 + fq * 4) = w;
            }
        }
        __syncthreads();
    }
    {
        const int nsec = 288 - G;
        if (nsec <= 0 || nsec >= G) deferred_weights(pp, lds, l, 512, 3392, false, bid, G, wid * 64 + lane);
        else if (bid >= nsec) deferred_weights(pp, lds, l, 512, 3392, false, bid - nsec, G - nsec, wid * 64 + lane);
    }
}

__device__ __forceinline__ void resnorm_phase(const bf16_t* Y, bf16_t* XB, float* RS, const float* gpost, float* OUT, int gwave, int nwaves, int lane) {
    f32x4 g[4];
#pragma unroll
    for (int i = 0; i < 4; ++i) g[i] = *(const f32x4*)(gpost + i * 256 + lane * 4);
    for (int r0 = gwave * 2; r0 < MT; r0 += nwaves * 2) {
        f32x4 x[2][4], y[2][4]; float ss[2] = {0.f, 0.f};
#pragma unroll
        for (int k = 0; k < 2; ++k)
#pragma unroll
            for (int i = 0; i < 4; ++i) { const size_t o = (size_t)(r0 + k) * 1024 + i * 256 + lane * 4;
                const u32x2 w = __builtin_nontemporal_load((const u32x2*)(Y + o)); y[k][i] = (f32x4){bf_lo(w.x), bf_hi(w.x), bf_lo(w.y), bf_hi(w.y)};
                const u32x2 v = *(const u32x2*)(XB + o); x[k][i] = (f32x4){bf_lo(v.x), bf_hi(v.x), bf_lo(v.y), bf_hi(v.y)}; }
#pragma unroll
        for (int k = 0; k < 2; ++k)
#pragma unroll
            for (int i = 0; i < 4; ++i) ss[k] += y[k][i][0] * y[k][i][0] + y[k][i][1] * y[k][i][1] + y[k][i][2] * y[k][i][2] + y[k][i][3] * y[k][i][3];
#pragma unroll
        for (int o = 32; o >= 1; o >>= 1) { ss[0] += shfl_xor_l(ss[0], o, lane); ss[1] += shfl_xor_l(ss[1], o, lane); }
        float s2[2] = {0.f, 0.f};
#pragma unroll
        for (int k = 0; k < 2; ++k) { const float rs = rsqrtf(ss[k] * (1.0f / 1024.0f) + 1e-6f);
#pragma unroll
            for (int i = 0; i < 4; ++i) { x[k][i] = x[k][i] + (y[k][i] * rs) * g[i];
                s2[k] += x[k][i][0] * x[k][i][0] + x[k][i][1] * x[k][i][1] + x[k][i][2] * x[k][i][2] + x[k][i][3] * x[k][i][3]; } }
        if (OUT) {
#pragma unroll
            for (int k = 0; k < 2; ++k)
#pragma unroll
                for (int i = 0; i < 4; ++i) __builtin_nontemporal_store(x[k][i], (f32x4*)(OUT + (size_t)(r0 + k) * 1024 + i * 256 + lane * 4));
        } else {
#pragma unroll
            for (int o = 32; o >= 1; o >>= 1) { s2[0] += shfl_xor_l(s2[0], o, lane); s2[1] += shfl_xor_l(s2[1], o, lane); }
            if (lane < 2) RS[r0 + lane] = rsqrtf((lane ? s2[1] : s2[0]) * (1.0f / 1024.0f) + 1e-6f);
#pragma unroll
            for (int k = 0; k < 2; ++k)
#pragma unroll
                for (int i = 0; i < 4; ++i) { u32x2 w; w.x = cvt_pk_bf16(x[k][i][0], x[k][i][1]); w.y = cvt_pk_bf16(x[k][i][2], x[k][i][3]);
                    *(u32x2*)(XB + (size_t)(r0 + k) * 1024 + i * 256 + lane * 4) = w; }
        }
    }
}

__device__ __forceinline__ void softmax_to_p(f32x4 (&sacc)[16], bf16x8 (&pf)[8], int lane) {
    float mx = -3.0e38f;
#pragma unroll
    for (int kb = 0; kb < 16; ++kb)
#pragma unroll
        for (int j = 0; j < 4; ++j) mx = fmaxf(mx, sacc[kb][j]);
    mx = fmaxf(mx, shfl_xor_l(mx, 16, lane)); mx = fmaxf(mx, shfl_xor_l(mx, 32, lane));
    float sum = 0.f; const float c = 0.0625f * 1.44269504f;
#pragma unroll
    for (int kb = 0; kb < 16; ++kb)
#pragma unroll
        for (int j = 0; j < 4; ++j) { const float e = __builtin_amdgcn_exp2f((sacc[kb][j] - mx) * c); sacc[kb][j] = e; sum += e; }
    sum += shfl_xor_l(sum, 16, lane); sum += shfl_xor_l(sum, 32, lane);
    const float inv = 1.0f / sum;
#pragma unroll
    for (int kk = 0; kk < 8; ++kk) { u32x4 w; w.x = cvt_pk_bf16(sacc[2 * kk][0] * inv, sacc[2 * kk][1] * inv); w.y = cvt_pk_bf16(sacc[2 * kk][2] * inv, sacc[2 * kk][3] * inv);
        w.z = cvt_pk_bf16(sacc[2 * kk + 1][0] * inv, sacc[2 * kk + 1][1] * inv); w.w = cvt_pk_bf16(sacc[2 * kk + 1][2] * inv, sacc[2 * kk + 1][3] * inv);
        pf[kk] = __builtin_bit_cast(bf16x8, w); }
}
__device__ __forceinline__ void attn_phase(LAS unsigned char* lds, const bf16_t* Q, bf16_t* O, const bf16_t* KPl, const bf16_t* VPTl, const bf16_t* KC, const bf16_t* VCT, int bid, int G, int tid, int wid, int lane) {
    const int fr = lane & 15, fq = lane >> 4;
    unsigned voffK[2], voffV[2];
#pragma unroll
    for (int i = 0; i < 2; ++i) { int R, C; pg8::stage_rc(tid * 16 + i * 8192, R, C); voffK[i] = (unsigned)(((R & ~31) + pg8::perm32(R & 31)) * 1024 + C) * 2u; voffV[i] = (unsigned)(R * 256 + C) * 2u; }
    const unsigned ldsw = (unsigned)wid * 1024u;
    const int koff = pg8::lds_byte(fr, fq * 8);
    for (int i = 0; i * G + bid < 512 + 128; ++i) {
        const int lin = i * G + bid;
        int h, R0; bool active; const bf16_t* Kb; const bf16_t* Vt;
        if (lin < 512) {
            int sh, qi;
            if ((G & 7) == 0 && G <= 512 && (512 % G) == 0) { const int x = bid & 7, j = (bid >> 3) + (G >> 3) * i; sh = x * 8 + (j >> 3); qi = j & 7; }
            else { sh = lin >> 3; qi = lin & 7; }
            const int s = sh >> 2; h = sh & 3; R0 = s * 2048 + qi * 256 + wid * 32; active = true;
            Kb = KPl + (size_t)s * 262144 + h * 256; Vt = VPTl + (size_t)(s * 4 + h) * 65536;
        } else {
            const int j = lin - 512, s = j >> 2; h = j & 3; R0 = MP + s * 32; active = (wid == 0);
            Kb = KC + (size_t)s * 262144 + h * 256; Vt = VCT + (size_t)(s * 4 + h) * 65536;
        }
#pragma unroll
        for (int c = 0; c < 4; ++c)
#pragma unroll
            for (int hh = 0; hh < 2; ++hh)
#pragma unroll
                for (int q = 0; q < 2; ++q)
                    __builtin_amdgcn_global_load_lds((const unsigned*)((const char*)(Kb + (size_t)hh * 128 * 1024 + c * 64) + voffK[q]), (LAS unsigned*)(lds + (c * 2 + hh) * pg8::HTB + ldsw + q * 8192), 16, 0, 0);
        const bf16_t* qp = Q + (size_t)(R0 + fr) * 1024 + h * 256 + fq * 8;
        bf16x8 qa[2], qb[2];
        qa[0] = *(const bf16x8*)(qp); qb[0] = *(const bf16x8*)(qp + 16 * 1024);
        asm volatile("s_waitcnt vmcnt(2)" ::: "memory");
        __syncthreads();
        f32x4 s0[16], s1[16];
#pragma unroll
        for (int kb = 0; kb < 16; ++kb) { s0[kb] = (f32x4){0.f, 0.f, 0.f, 0.f}; s1[kb] = (f32x4){0.f, 0.f, 0.f, 0.f}; }
        bf16x8 p0[8], p1[8];
        if (active) {
#pragma unroll
        for (int ks = 0; ks < 8; ++ks) {
            __builtin_amdgcn_sched_barrier(0);
            if (ks + 1 < 8) { qa[(ks + 1) % 2] = *(const bf16x8*)(qp + (ks + 1) * 32); qb[(ks + 1) % 2] = *(const bf16x8*)(qp + 16 * 1024 + (ks + 1) * 32); }
#pragma unroll
            for (int kb = 0; kb < 16; ++kb) {
                const bf16x8 kf = *(const LAS bf16x8*)(lds + ((ks >> 1) * 2 + (kb >> 3)) * pg8::HTB + koff + (kb & 7) * 2048 + (ks & 1) * 1024);
                s0[kb] = __builtin_amdgcn_mfma_f32_16x16x32_bf16(kf, qa[ks % 2], s0[kb], 0, 0, 0);
                s1[kb] = __builtin_amdgcn_mfma_f32_16x16x32_bf16(kf, qb[ks % 2], s1[kb], 0, 0, 0);
            }
        }
        __builtin_amdgcn_sched_barrier(0);
        softmax_to_p(s0, p0, lane); softmax_to_p(s1, p1, lane);
        }
        __syncthreads();
#pragma unroll
        for (int c = 0; c < 4; ++c)
#pragma unroll
            for (int hh = 0; hh < 2; ++hh)
#pragma unroll
                for (int q = 0; q < 2; ++q)
                    __builtin_amdgcn_global_load_lds((const unsigned*)((const char*)(Vt + (size_t)hh * 128 * 256 + c * 64) + voffV[q]), (LAS unsigned*)(lds + (c * 2 + hh) * pg8::HTB + ldsw + q * 8192), 16, 0, 0);
        asm volatile("s_waitcnt vmcnt(0)" ::: "memory");
        __syncthreads();
        if (active) {
        int fr2 = fr, fq2 = fq; asm volatile("" : "+v"(fr2), "+v"(fq2));
        const int koff2 = pg8::lds_byte(fr2, fq2 * 8);
#pragma unroll
        for (int dg = 0; dg < 4; ++dg) {
            __builtin_amdgcn_sched_barrier(0);
            f32x4 a0[4], a1[4];
#pragma unroll
            for (int d = 0; d < 4; ++d) { a0[d] = (f32x4){0.f, 0.f, 0.f, 0.f}; a1[d] = (f32x4){0.f, 0.f, 0.f, 0.f}; }
#pragma unroll
            for (int kk = 0; kk < 8; ++kk)
#pragma unroll
                for (int d = 0; d < 4; ++d) {
                    const int db = dg * 4 + d;
                    const bf16x8 vf = *(const LAS bf16x8*)(lds + ((kk >> 1) * 2 + (db >> 3)) * pg8::HTB + koff2 + (db & 7) * 2048 + (kk & 1) * 1024);
                    a0[d] = __builtin_amdgcn_mfma_f32_16x16x32_bf16(vf, p0[kk], a0[d], 0, 0, 0);
                    a1[d] = __builtin_amdgcn_mfma_f32_16x16x32_bf16(vf, p1[kk], a1[d], 0, 0, 0);
                }
#pragma unroll
            for (int d = 0; d < 4; ++d) { const int db = dg * 4 + d;
                u32x2 w; w.x = cvt_pk_bf16(a0[d][0], a0[d][1]); w.y = cvt_pk_bf16(a0[d][2], a0[d][3]);
                *(u32x2*)(O + (size_t)(R0 + fr2) * 1024 + h * 256 + db * 16 + fq2 * 4) = w;
                w.x = cvt_pk_bf16(a1[d][0], a1[d][1]); w.y = cvt_pk_bf16(a1[d][2], a1[d][3]);
                *(u32x2*)(O + (size_t)(R0 + 16 + fr2) * 1024 + h * 256 + db * 16 + fq2 * 4) = w; }
        }
        }
        __syncthreads();
    }
}

__device__ __forceinline__ void load_raw8(const bf16_t* RAW, const float* hist, int blk, int slot, int hidx, bool use_hist, bool zero, int col, float* f) {
    if (zero) {
#pragma unroll
        for (int q = 0; q < 8; ++q) f[q] = 0.f; }
    else if (use_hist) { const float* hp = hist + (size_t)hidx * NUP + col; const f32x4 a = *(const f32x4*)hp, b = *(const f32x4*)(hp + 4);
        f[0] = a[0]; f[1] = a[1]; f[2] = a[2]; f[3] = a[3]; f[4] = b[0]; f[5] = b[1]; f[6] = b[2]; f[7] = b[3]; }
    else unpack8(*(const u32x4*)(RAW + ((size_t)blk * 4 + slot) * NUP + col), f);
}
__device__ __forceinline__ void fixup_phase(PP pp, int l, int gtid, int nthr) {
    const bf16_t* RAW = (const bf16_t*)(pp->ws + BIG_RAW); bf16_t* ACT = (bf16_t*)(pp->ws + BIG_ACT);
    const float* cw = pp->in[I_FCW] + (size_t)l * 3 * NUP; const float* cb = pp->in[I_FCB] + (size_t)l * NUP;
    const float* sffn = pp->in[I_SFFN] + (size_t)l * 32 * 2 * NUP;
    for (int idx = gtid; idx < (MP / 32 + (MT - MP) / 16) * 352; idx += nthr) {
        const int rowi = idx / 352, ch = idx % 352, q = rowi & 1, blk = rowi < MP / 32 ? (rowi >> 1) * 2 : MP / 32 + ((rowi - MP / 32) >> 1), R = blk * 32 + q, f0 = ch * 8;
        const bool prompt = R < MP; const int t = prompt ? (R & 2047) : q;
        const float* hist = prompt ? sffn : sffn + (size_t)((R - MP) >> 5) * 2 * NUP;
        float act[8], cg[8], cvv[8];
#pragma unroll
        for (int part = 0; part < 2; ++part) {
            const int col = part * DFF + f0; float x0[8], x1[8], x2[8];
            load_raw8(RAW, hist, blk, 2 + q, 0, false, false, col, x0);
            { const bool in = (t - 1) >= 0; load_raw8(RAW, hist, q ? blk : blk - 1, q ? 2 : 1, 1, !in, !in && prompt, col, x1); }
            { const bool in = (t - 2) >= 0; load_raw8(RAW, hist, blk - 1, q ? 1 : 0, q ? 1 : 0, !in, !in && prompt, col, x2); }
            const f32x4 w0a = *(const f32x4*)(cw + col), w0b = *(const f32x4*)(cw + col + 4), w1a = *(const f32x4*)(cw + NUP + col), w1b = *(const f32x4*)(cw + NUP + col + 4),
                        w2a = *(const f32x4*)(cw + 2 * NUP + col), w2b = *(const f32x4*)(cw + 2 * NUP + col + 4), ba = *(const f32x4*)(cb + col), bb = *(const f32x4*)(cb + col + 4);
#pragma unroll
            for (int k = 0; k < 8; ++k) { const float w0 = k < 4 ? w0a[k & 3] : w0b[k & 3], w1 = k < 4 ? w1a[k & 3] : w1b[k & 3], w2 = k < 4 ? w2a[k & 3] : w2b[k & 3], bbv = k < 4 ? ba[k & 3] : bb[k & 3];
                const float z = w0 * x2[k] + w1 * x1[k] + w2 * x0[k] + bbv; if (part == 0) cg[k] = z; else cvv[k] = z; }
        }
#pragma unroll
        for (int k = 0; k < 8; ++k) act[k] = silu_f(cg[k]) * cvv[k];
        *(u32x4*)(ACT + (size_t)R * DFF + f0) = pack8(act);
    }
}

#ifndef DBG_NSTEP
#define DBG_NSTEP (2 + 13 * 2)
#endif
constexpr int NSTEP = DBG_NSTEP;
__global__ void __launch_bounds__(512, 2) mega(Params p_) {
    extern __shared__ __attribute__((aligned(16))) unsigned char shm[];
    LAS unsigned char* lds = (LAS unsigned char*)shm;
    cg::grid_group grid = cg::this_grid();
    { volatile LAS unsigned* st = (volatile LAS unsigned*)(lds + LDS_ST);
      int t0 = threadIdx.x; PP p0 = (PP)__builtin_amdgcn_kernarg_segment_ptr();
      if (t0 < 4) st[t0] = 0u;
      __syncthreads();
      (void)xcd_barrier_post((unsigned*)(p0->ws + WS_CTL), st, t0); }

    int tid = threadIdx.x, G = gridDim.x, bid = blockIdx.x;
    for (int step = 0; step < NSTEP; ++step) {
        asm volatile("" : "+v"(tid));
        asm volatile("" : "+s"(G), "+s"(bid));
        const __attribute__((address_space(4))) Params* pp = (const __attribute__((address_space(4))) Params*)__builtin_amdgcn_kernarg_segment_ptr();
        asm volatile("" : "+s"(pp));
        const int lane = tid & 63, wid = __builtin_amdgcn_readfirstlane(tid >> 6);
        const int gtid = bid * 512 + tid, nthr = G * 512, gwave = bid * 8 + wid, nwaves = G * 8;
        bf16_t* XB = (bf16_t*)(pp->ws + WS_H); bf16_t* Y = (bf16_t*)(pp->ws + WS_Y);
        float* RS = (float*)(pp->ws + WS_RS);
        if (step == 0) { prep_phase(pp, lds, bid, G, tid, wid, lane); }
        else if (step == 1) {
            pg8::Gemm g{(const bf16_t*)(pp->ws + WS_MEMN), (const bf16_t*)(pp->ws + WS_WKV), 8192, 4096, 1024};
            pg8::KvOrder S{G, bid};
            pg8::EpiKV E{pp->out + O_MK, pp->out + O_MV, (bf16_t*)(pp->ws + WS_KP), (bf16_t*)(pp->ws + WS_VROW)};
            pg8::gemm_phase<pg8::EpiKV, pg8::KvOrder>(lds, g, S, E, tid);
        } else {
            const int l = (step - 2) / 13, k = (step - 2) % 13;
            const bf16_t* WL = (const bf16_t*)(pp->ws + WS_W) + (size_t)l * WL_ELEMS;
            bool is_gemm = false; pg8::Gemm g{nullptr, nullptr, MT, 1024, 1024}; pg8::EpiBf16 E{nullptr, 1024, nullptr};
            switch (k) {
            case 0: g = pg8::Gemm{XB, WL + WL_WIN, MT, 2048, 1024}; E = pg8::EpiBf16{(bf16_t*)(pp->ws + BIG_PROJ), 2048, RS}; is_gemm = true; break;
            case 1: mixer_phase(pp, lds, l, bid, G, wid, lane); break;
            case 2: break;
            case 3: g = pg8::Gemm{(const bf16_t*)(pp->ws + BIG_YCAT), WL + WL_WOUT, MT, 1024, 1024}; E = pg8::EpiBf16{Y, 1024, nullptr}; is_gemm = true; break;
            case 4: resnorm_phase(Y, XB, RS, pp->in[I_GMIXPOST] + l * 1024, nullptr, gwave, nwaves, lane); break;
            case 5: g = pg8::Gemm{XB, WL + WL_WQ, MT, 1024, 1024}; E = pg8::EpiBf16{(bf16_t*)(pp->ws + BIG_Q), 1024, RS}; is_gemm = true; break;
            case 6: attn_phase(lds, (const bf16_t*)(pp->ws + BIG_Q), (bf16_t*)(pp->ws + BIG_O), (const bf16_t*)(pp->ws + WS_KP) + (size_t)l * 4096 * 1024, (const bf16_t*)(pp->ws + WS_VPT) + (size_t)l * 4096 * 1024,
                               (const bf16_t*)(pp->ws + WS_KC), (const bf16_t*)(pp->ws + WS_VCT), bid, G, tid, wid, lane); break;
            case 7: g = pg8::Gemm{(const bf16_t*)(pp->ws + BIG_O), WL + WL_WO, MT, 1024, 1024}; E = pg8::EpiBf16{Y, 1024, nullptr}; is_gemm = true; break;
            case 8: resnorm_phase(Y, XB, RS, pp->in[I_GATTPOST] + l * 1024, nullptr, gwave, nwaves, lane);
                    break;
            case 9: {
                pg8::Gemm gu{XB, WL + WL_WUP, MT, NUP, 1024}; pg8::StaticOrder S; S.init(MT, NUP, G, bid);
                pg8::EpiUp EU{(bf16_t*)(pp->ws + BIG_ACT), (bf16_t*)(pp->ws + BIG_RAW), pp->in[I_FCW] + (size_t)l * 3 * NUP, pp->in[I_FCB] + (size_t)l * NUP,
                              pp->out + O_FFNP + (size_t)l * 16 * 2 * NUP, pp->out + O_FFNS + (size_t)l * 32 * 2 * NUP, RS, lds};
                pg8::gemm_phase<pg8::EpiUp, pg8::StaticOrder>(lds, gu, S, EU, tid);
                if (l == 0) {
                    const int rem = S.nwg % G;
                    const int rk = rem == 0 ? bid : bid - rem, nrk = rem == 0 ? G : G - rem;
                    if (rk >= 0) { deferred_weights(pp, lds, 1, 0, 512, true, rk, nrk, tid);
                        convert_cache(pp->in[I_CK] + (size_t)32 * 256 * 1024, pp->in[I_CV] + (size_t)32 * 256 * 1024, (bf16_t*)(pp->ws + WS_KC), (bf16_t*)(pp->ws + WS_VCT), lds, rk, nrk, tid, rk * 512 + tid, nrk * 512); }
                }
            } break;
            case 10: fixup_phase(pp, l, gtid, nthr); break;
            case 11: g = pg8::Gemm{(const bf16_t*)(pp->ws + BIG_ACT), WL + WL_WDOWN, MT, 1024, DFF}; E = pg8::EpiBf16{Y, 1024, nullptr}; is_gemm = true; break;
            case 12: resnorm_phase(Y, XB, RS, pp->in[I_GFFNPOST] + l * 1024, l == 1 ? pp->out + O_Y : nullptr, gwave, nwaves, lane); break;
            }
            if (is_gemm) {
                pg8::StaticOrder S; S.init(MP, g.N, G, bid); pg8::gemm_phase<pg8::EpiBf16, pg8::StaticOrder>(lds, g, S, E, tid);
                small_gemm(lds, g.A, g.Bt, g.N, g.K, E.O, E.ldc, E.rs, bid, G, tid, wid, lane);
            }
        }
        if (pp->ws == nullptr) grid.sync();
        if (step != 1 && !(step >= 2 && (step - 2) % 13 == 2) && step != NSTEP - 1) {
            XcdBarrier xb; xb.bar = (unsigned*)(pp->ws + WS_CTL); xb.x = xb_xcc_id(); xb.st = (volatile LAS unsigned*)(lds + LDS_ST);
            xcd_barrier(xb, tid, (unsigned)G);
        }
    }
}

extern "C" void kernel_launch(void* const* d_in, const int* in_sizes, int n_in, void* d_out, int out_size, void* d_ws, size_t ws_size, hipStream_t stream) {
    static int grid_blocks = 0;
    if (!grid_blocks) {
        int dev = 0, cus = 0, per_cu = 0;
        hipGetDevice(&dev);
        hipDeviceGetAttribute(&cus, hipDeviceAttributeMultiprocessorCount, dev);
        hipFuncSetAttribute((const void*)mega, hipFuncAttributeMaxDynamicSharedMemorySize, LDS_BYTES);
        hipOccupancyMaxActiveBlocksPerMultiprocessor(&per_cu, (const void*)mega, 512, LDS_BYTES);
        if (per_cu < 1) per_cu = 1;
        grid_blocks = cus * per_cu;
        if (ws_size < 500 * MiB) fprintf(stderr, "kernel_launch: workspace too small: %zu\n", ws_size);
    }
    Params p{};
    for (int i = 0; i < 29; ++i) p.in[i] = (const float*)d_in[i];
    p.out = (float*)d_out; p.ws = (unsigned char*)d_ws;
    (void)hipMemsetAsync((char*)d_ws + WS_CTL, 0, XCD_BAR_WORDS * 4, stream);
    void* args[] = {&p};
    hipError_t e = hipLaunchCooperativeKernel((const void*)mega, dim3(grid_blocks), dim3(512), args, LDS_BYTES, stream);
    if (e != hipSuccess) fprintf(stderr, "cooperative launch failed: %s (grid %d)\n", hipGetErrorString(e), grid_blocks);
}
```
